# Optimizing an MI355X kernel written in HIP

```python
import math
import jax, jax.numpy as jnp
from jax import lax
import numpy as np

D_MODEL = 1024
BATCH = 8
SEQ = 4096
DEPTH = 1

GRID_W = 64
BLOCK = 128
WINDOW = 128
A_HEADS = 8
A_KV_HEADS = 2
A_HEAD_DIM = 64
B_HEADS = 4
B_KV_HEADS = 2
B_HEAD_DIM = 128
ROPE_THETA = 10000.0
D_FF = 2816
CONV_W = 3
LN_EPS = 1e-5
RMS_EPS = 1e-6
DEEPNORM_ALPHA = float((2 * DEPTH) ** 0.25)
DEEPNORM_BETA = float((8 * DEPTH) ** -0.25)

A_Q = A_HEADS * A_HEAD_DIM
A_KV = A_KV_HEADS * A_HEAD_DIM
B_Q = B_HEADS * B_HEAD_DIM
B_KV = B_KV_HEADS * B_HEAD_DIM
IN_WIDTHS = (A_Q, A_KV, A_KV, B_Q, B_KV, B_KV, D_MODEL, D_MODEL)
IN_SPLIT_POINTS = tuple(int(v) for v in np.cumsum(IN_WIDTHS)[:-1])
IN_TOTAL = int(sum(IN_WIDTHS))

kernel_name = "hybrid_gated_window_axial_gqa_convglu_deepnorm"


def layer_norm(x, g, b):
    xf = x.astype(jnp.float32)
    mu = xf.mean(-1, keepdims=True)
    var = jnp.square(xf - mu).mean(-1, keepdims=True)
    return ((xf - mu) * lax.rsqrt(var + LN_EPS) * g.astype(jnp.float32) + b.astype(jnp.float32)).astype(x.dtype)


def rms_norm(x, scale):
    xf = x.astype(jnp.float32)
    y = xf * lax.rsqrt(jnp.mean(xf * xf, axis=-1, keepdims=True) + RMS_EPS) * scale.astype(jnp.float32)
    return y.astype(x.dtype)


def alibi_slopes(n_heads):
    return jnp.exp2(-8.0 * jnp.arange(1, n_heads + 1, dtype=jnp.float32) / n_heads)


def rotate_axis(xs, pos):
    n = xs.shape[-1] // 2
    freqs = ROPE_THETA ** (-jnp.arange(n, dtype=jnp.float32) / n)
    ang = pos.astype(jnp.float32)[:, None] * freqs[None, :]
    cos = jnp.cos(ang)[None, :, None, :]
    sin = jnp.sin(ang)[None, :, None, :]
    x1 = xs[..., :n].astype(jnp.float32)
    x2 = xs[..., n:].astype(jnp.float32)
    return jnp.concatenate([x1 * cos - x2 * sin, x1 * sin + x2 * cos], axis=-1)


def axial_rope(x, rows, cols):
    half = x.shape[-1] // 2
    y = jnp.concatenate([rotate_axis(x[..., :half], rows), rotate_axis(x[..., half:], cols)], axis=-1)
    return y.astype(x.dtype)


def window_attention(q, k, v, sinks):
    bsz, s_len, hq, dh = q.shape
    hkv = k.shape[2]
    grp = hq // hkv
    nb = s_len // BLOCK
    qb = q.reshape(bsz, nb, BLOCK, hkv, grp, dh)
    pad = ((0, 0), (BLOCK, BLOCK), (0, 0), (0, 0))

    def band(t):
        tp = jnp.pad(t, pad).reshape(bsz, nb + 2, BLOCK, hkv, dh)
        return jnp.concatenate([tp[:, :-2], tp[:, 1:-1], tp[:, 2:]], axis=2)

    kb, vb = band(k), band(v)
    scores = jnp.einsum('bnqkgd,bnskd->bnkgqs', qb, kb).astype(jnp.float32) * (dh ** -0.5)

    blk = jnp.arange(nb)
    qpos = blk[:, None] * BLOCK + jnp.arange(BLOCK)[None, :]
    kpos = (blk[:, None] - 1) * BLOCK + jnp.arange(3 * BLOCK)[None, :]
    dist = jnp.abs(qpos[:, :, None] - kpos[:, None, :])
    valid = (dist <= WINDOW) & (kpos[:, None, :] >= 0) & (kpos[:, None, :] < s_len)
    slopes = alibi_slopes(hq).reshape(hkv, grp)
    bias = -slopes[None, :, :, None, None] * dist.astype(jnp.float32)[:, None, None, :, :]
    neg = jnp.finfo(jnp.float32).min
    scores = jnp.where(valid[:, None, None, :, :], scores + bias, neg)

    sink = sinks.astype(jnp.float32).reshape(hkv, grp)[:, :, None, None]
    m = jnp.maximum(scores.max(-1, keepdims=True), sink)
    p = jnp.exp(scores - m)
    p = p / (p.sum(-1, keepdims=True) + jnp.exp(sink - m))
    o = jnp.einsum('bnkgqs,bnskd->bnqkgd', p.astype(v.dtype), vb)
    return o.reshape(bsz, s_len, hq * dh)


def global_attention(q, k, v):
    bsz, s_len, hq, dh = q.shape
    hkv = k.shape[2]
    grp = hq // hkv
    nb = s_len // BLOCK
    qb = q.reshape(bsz, nb, BLOCK, hkv, grp, dh).transpose(1, 0, 2, 3, 4, 5)
    scale = dh ** -0.5

    def one_block(qi):
        s = jnp.einsum('bqkgd,bskd->bkgqs', qi, k).astype(jnp.float32) * scale
        p = jax.nn.softmax(s, axis=-1).astype(v.dtype)
        return jnp.einsum('bkgqs,bskd->bqkgd', p, v)

    o = lax.map(one_block, qb)
    return o.transpose(1, 0, 2, 3, 4, 5).reshape(bsz, s_len, hq * dh)


def token_mixer(h, w_in, b_in, a_sinks, b_q_norm, b_k_norm, w_o_a, w_o_b, w_out, rows, cols):
    bsz, s_len, _ = h.shape
    u = h @ w_in + b_in
    qa, ka, va, qb, kb, vb, ga, gb = jnp.split(u, IN_SPLIT_POINTS, axis=-1)
    qa = qa.reshape(bsz, s_len, A_HEADS, A_HEAD_DIM)
    ka = ka.reshape(bsz, s_len, A_KV_HEADS, A_HEAD_DIM)
    va = va.reshape(bsz, s_len, A_KV_HEADS, A_HEAD_DIM)
    oa = window_attention(qa, ka, va, a_sinks)
    qb = axial_rope(rms_norm(qb.reshape(bsz, s_len, B_HEADS, B_HEAD_DIM), b_q_norm), rows, cols)
    kb = axial_rope(rms_norm(kb.reshape(bsz, s_len, B_KV_HEADS, B_HEAD_DIM), b_k_norm), rows, cols)
    vb = vb.reshape(bsz, s_len, B_KV_HEADS, B_HEAD_DIM)
    ob = global_attention(qb, kb, vb)
    merged = jax.nn.sigmoid(ga) * (oa @ w_o_a) + jax.nn.sigmoid(gb) * (ob @ w_o_b)
    return merged @ w_out


def conv_glu(h, w_gate, w_val, conv_w, conv_b, w_down):
    g = h @ w_gate
    g = lax.conv_general_dilated(
        g, conv_w[:, None, :].astype(g.dtype), window_strides=(1,),
        padding=((CONV_W // 2, CONV_W // 2),),
        dimension_numbers=('NWC', 'WIO', 'NWC'),
        feature_group_count=g.shape[-1]) + conv_b
    act = jax.nn.gelu(g, approximate=False) * (h @ w_val)
    return act @ w_down


def setup_inputs(seed: int = 0) -> dict:
    key = jax.random.key(seed)
    ks = jax.random.split(key, 24)
    f32 = jnp.float32

    def nrm(k, shape, scale):
        return jax.random.normal(k, shape, f32) * scale

    x = jax.random.normal(ks[0], (BATCH, SEQ, D_MODEL), f32)
    ln_in_g = 1.0 + nrm(ks[1], (D_MODEL,), 0.02)
    ln_in_b = nrm(ks[2], (D_MODEL,), 0.02)
    col_scale = jnp.concatenate([
        jnp.full((w,), DEEPNORM_BETA if i in (2, 5) else 1.0, f32) for i, w in enumerate(IN_WIDTHS)])
    w_in = nrm(ks[3], (DEPTH, D_MODEL, IN_TOTAL), D_MODEL ** -0.5) * col_scale
    b_in = nrm(ks[4], (DEPTH, IN_TOTAL), 0.02)
    a_sinks = nrm(ks[5], (DEPTH, A_HEADS), 0.5)
    b_q_norm = 1.0 + nrm(ks[6], (DEPTH, B_HEAD_DIM), 0.02)
    b_k_norm = 1.0 + nrm(ks[7], (DEPTH, B_HEAD_DIM), 0.02)
    w_o_a = nrm(ks[8], (DEPTH, A_Q, D_MODEL), A_Q ** -0.5 * DEEPNORM_BETA)
    w_o_b = nrm(ks[9], (DEPTH, B_Q, D_MODEL), B_Q ** -0.5 * DEEPNORM_BETA)
    w_out = nrm(ks[10], (DEPTH, D_MODEL, D_MODEL), D_MODEL ** -0.5 * DEEPNORM_BETA)
    ln1_g = 1.0 + nrm(ks[11], (DEPTH, D_MODEL), 0.02)
    ln1_b = nrm(ks[12], (DEPTH, D_MODEL), 0.02)
    w_ffn_gate = nrm(ks[13], (DEPTH, D_MODEL, D_FF), D_MODEL ** -0.5 * DEEPNORM_BETA)
    w_ffn_val = nrm(ks[14], (DEPTH, D_MODEL, D_FF), D_MODEL ** -0.5 * DEEPNORM_BETA)
    ffn_conv_w = nrm(ks[15], (DEPTH, CONV_W, D_FF), CONV_W ** -0.5)
    ffn_conv_b = nrm(ks[16], (DEPTH, D_FF), 0.02)
    w_ffn_down = nrm(ks[17], (DEPTH, D_FF, D_MODEL), D_FF ** -0.5 * DEEPNORM_BETA)
    ln2_g = 1.0 + nrm(ks[18], (DEPTH, D_MODEL), 0.02)
    ln2_b = nrm(ks[19], (DEPTH, D_MODEL), 0.02)
    return {"x": x, "ln_in_g": ln_in_g, "ln_in_b": ln_in_b, "w_in": w_in, "b_in": b_in,
            "a_sinks": a_sinks, "b_q_norm": b_q_norm, "b_k_norm": b_k_norm,
            "w_o_a": w_o_a, "w_o_b": w_o_b, "w_out": w_out, "ln1_g": ln1_g, "ln1_b": ln1_b,
            "w_ffn_gate": w_ffn_gate, "w_ffn_val": w_ffn_val, "ffn_conv_w": ffn_conv_w,
            "ffn_conv_b": ffn_conv_b, "w_ffn_down": w_ffn_down, "ln2_g": ln2_g, "ln2_b": ln2_b}


def reference(x, ln_in_g, ln_in_b, w_in, b_in, a_sinks, b_q_norm, b_k_norm, w_o_a, w_o_b, w_out,
              ln1_g, ln1_b, w_ffn_gate, w_ffn_val, ffn_conv_w, ffn_conv_b, w_ffn_down, ln2_g, ln2_b):
    s_len = x.shape[1]
    n_rows = s_len // GRID_W
    rows = jnp.repeat(jnp.arange(n_rows), GRID_W)
    cols = jnp.tile(jnp.arange(GRID_W), n_rows)
    h = layer_norm(x, ln_in_g, ln_in_b)
    for l in range(DEPTH):
        y = token_mixer(h, w_in[l], b_in[l], a_sinks[l], b_q_norm[l], b_k_norm[l],
                        w_o_a[l], w_o_b[l], w_out[l], rows, cols)
        h = layer_norm(DEEPNORM_ALPHA * h + y, ln1_g[l], ln1_b[l])
        y = conv_glu(h, w_ffn_gate[l], w_ffn_val[l], ffn_conv_w[l], ffn_conv_b[l], w_ffn_down[l])
        h = layer_norm(DEEPNORM_ALPHA * h + y, ln2_g[l], ln2_b[l])
    return h
```

```cpp
#define DBG 0
#include <hip/hip_runtime.h>
#include <hip/hip_bf16.h>
#include <hip/hip_cooperative_groups.h>
#include <cstdio>
#include <cstdint>
#include <cmath>
namespace cg = cooperative_groups;
#define XB_LAS __attribute__((address_space(3)))
#define XB_TMO      128
#define XB_XCNT(j)  (256  + 64 * (j))
#define XB_XSUB(j)  (1280 + 64 * (j))
#define XB_XGEN(j)  (2304 + 64 * (j))
#define XB_TOP      3328
#define XB_TOPGEN   3392
#define XCD_BAR_WORDS 3456
#define XB_SPIN_CAP (1u << 18)
__device__ __forceinline__ unsigned xb_ld(unsigned* p)              { return __hip_atomic_load(p, __ATOMIC_RELAXED, __HIP_MEMORY_SCOPE_AGENT); }
__device__ __forceinline__ unsigned xb_add(unsigned* p, unsigned v) { return __hip_atomic_fetch_add(p, v, __ATOMIC_RELAXED, __HIP_MEMORY_SCOPE_AGENT); }
__device__ __forceinline__ unsigned xb_xcc_id() { return (unsigned)__builtin_amdgcn_s_getreg((3 << 11) | 20) & 0xFu; }
#define XB_SPIN(cond, bar) do { unsigned _sp = 0; while (cond) { __builtin_amdgcn_s_sleep(1); \
    if ((++_sp & 255u) == 0u) { if (xb_ld(&(bar)[XB_TMO])) break; if (_sp > XB_SPIN_CAP) { atomicAdd(&(bar)[XB_TMO], 1u); break; } } } } while (0)
struct XcdBarrier { unsigned* bar; unsigned x; volatile XB_LAS unsigned* st; };
__device__ __forceinline__ XcdBarrier xcd_barrier_post(unsigned* bar, volatile XB_LAS unsigned* st) {
    XcdBarrier b; b.bar = bar; b.x = xb_xcc_id(); b.st = st;
    if (threadIdx.x == 0) (void)xb_add(&bar[XB_XCNT(b.x)], 1u);
    return b;
}
__device__ __forceinline__ void xcd_barrier_complete(unsigned* bar, unsigned x, unsigned& nloc, unsigned& nx) {
    const unsigned G = gridDim.x * gridDim.y * gridDim.z;
    unsigned sum, cnt, mine, sp = 0u;
    for (;;) {
        sum = 0u; cnt = 0u; mine = 0u;
#pragma unroll
        for (unsigned j = 0; j < 16; ++j) { const unsigned c = xb_ld(&bar[XB_XCNT(j)]); sum += c; cnt += (c > 0u) ? 1u : 0u; mine = (j == x) ? c : mine; }
        if (sum == G) break;
        __builtin_amdgcn_s_sleep(1);
        if ((++sp & 255u) == 0u) { if (xb_ld(&bar[XB_TMO])) break; if (sp > XB_SPIN_CAP) { atomicAdd(&bar[XB_TMO], 1u); break; } }
    }
    nloc = mine > 0u ? mine : 1u; nx = cnt > 0u ? cnt : 1u;
}
__device__ __forceinline__ void xcd_barrier(const XcdBarrier& b) {
    asm volatile("s_waitcnt vmcnt(0)" ::: "memory");
    __syncthreads();
    if (threadIdx.x == 0) {
        unsigned* bar = b.bar;
        __builtin_amdgcn_s_waitcnt(0);
        unsigned nloc = b.st[0], nx = b.st[1];
        if (nloc == 0u) { xcd_barrier_complete(bar, b.x, nloc, nx); b.st[0] = nloc; b.st[1] = nx; }
        const unsigned old = xb_add(&bar[XB_XSUB(b.x)], 1u);
        const unsigned gen = old / nloc;
        if (old + 1u == (gen + 1u) * nloc) {
            __builtin_amdgcn_fence(__ATOMIC_RELEASE, "agent");
            asm volatile("s_waitcnt vmcnt(0)" ::: "memory");
            const unsigned og = xb_add(&bar[XB_TOP], 1u);
            const unsigned tg = og / nx;
            if (og + 1u == (tg + 1u) * nx) xb_add(&bar[XB_TOPGEN], 1u);
            else XB_SPIN(xb_ld(&bar[XB_TOPGEN]) == tg, bar);
            __builtin_amdgcn_fence(__ATOMIC_ACQUIRE, "agent");
            xb_add(&bar[XB_XGEN(b.x)], 1u);
            asm volatile("s_waitcnt vmcnt(0)" ::: "memory");
        } else {
            XB_SPIN(xb_ld(&bar[XB_XGEN(b.x)]) == gen, bar);
            __builtin_amdgcn_fence(__ATOMIC_ACQUIRE, "agent");
            asm volatile("s_waitcnt vmcnt(0)" ::: "memory");
        }
    }
    __syncthreads();
}
namespace pg8 {
#define PG8_LAS __attribute__((address_space(3)))
typedef unsigned short bf16_t;
typedef short bf16x8 __attribute__((ext_vector_type(8)));
typedef float f32x4 __attribute__((ext_vector_type(4)));
typedef float f32x2 __attribute__((ext_vector_type(2)));
typedef unsigned u32x4 __attribute__((ext_vector_type(4)));
typedef unsigned u32x2 __attribute__((ext_vector_type(2)));
constexpr int BM = 256, BK = 64, HALF = 128, HTB = HALF * BK * 2  , STAGE_BYTES = 8 * HTB, NXCD = 8, WGM = 8;

__host__ __device__ __forceinline__ int lds_byte(int r, int c) { const int st = (r >> 4) * 2 + (c >> 5), rr = r & 15, cc = c & 31, ob = rr * 64 + cc * 2; return st * 1024 + (ob ^ (((ob >> 9) & 1) << 5)); }
__host__ __device__ __forceinline__ void stage_rc(int b, int& R, int& C) { const int st = b / 1024, sb = b % 1024, swz = sb ^ (((sb >> 9) & 1) << 5); R = (st >> 1) * 16 + swz / 64; C = (st & 1) * 32 + (swz % 64) / 2; }
__host__ __device__ __forceinline__ int perm32(int rho) { const int n = rho >> 4, i = rho & 15; return 8 * (i >> 2) + 4 * n + (i & 3); }

struct Unit { int pm, pn, sub; };
struct Gemm { const bf16_t* A; const bf16_t* Bt; int lda, ldb, K; };

struct StaticOrder {
    int nM, nN, nwg, G, c, nsub;
    __host__ __device__ void init(int M, int N, int G_, int c_, int nsub_ = 1) { nM = M / BM; nN = N / BM; nwg = nM * nN; G = G_; c = c_; nsub = nsub_; }
    __host__ __device__ bool next(int i, Unit& u) const {
        const int it = i / nsub; u.sub = i - it * nsub;
        const long L = (long)it * G + c; if (L >= nwg) return false;
        int wgid = (int)L; { const int q = nwg / NXCD, r = nwg % NXCD, xcd = wgid % NXCD, off = wgid / NXCD; wgid = (xcd < r ? xcd * (q + 1) : r * (q + 1) + (xcd - r) * q) + off; }
        const int nig = WGM * nN, gid = wgid / nig, fm = gid * WGM, gsz = (nM - fm) < WGM ? (nM - fm) : WGM;
        u.pm = fm + ((wgid % nig) % gsz); u.pn = (wgid % nig) / gsz; return true;
    }
};

__device__ __forceinline__ unsigned cvt_pk_bf16(float lo, float hi) { unsigned r; asm volatile("v_cvt_pk_bf16_f32 %0, %1, %2" : "=v"(r) : "v"(lo), "v"(hi)); return r; }
__device__ __forceinline__ float bflo(unsigned w) { return __uint_as_float(w << 16); }
__device__ __forceinline__ float bfhi(unsigned w) { return __uint_as_float(w & 0xffff0000u); }
__device__ __forceinline__ f32x2 gelu_pk(f32x2 v) {
    const f32x2 av = __builtin_elementwise_abs(v), d = av * 0.2316418882f + 1.0f;
    f32x2 t; t.x = __builtin_amdgcn_rcpf(d.x); t.y = __builtin_amdgcn_rcpf(d.y);
    f32x2 q = t * 0.5307027145f + (-0.7265760135f); q = q * t + 0.7107068705f; q = q * t + (-0.142248368f); q = q * t + 0.127414796f; q = q * t;
    const f32x2 s = (v * v) * (-0.72134752044f);
    f32x2 e; e.x = __builtin_amdgcn_exp2f(s.x); e.y = __builtin_amdgcn_exp2f(s.y);
    const f32x2 m = v * (q * e), r = v - m;
    f32x2 o; o.x = v.x < 0.f ? m.x : r.x; o.y = v.y < 0.f ? m.y : r.y; return o;
}

template <class Epi, class Sched, bool ALIGN_EPI>
__device__ __forceinline__ void gemm_phase(PG8_LAS unsigned char* lds, PG8_LAS unsigned char* xlds, const Gemm g, const Sched& S, const Epi& E) {
    int tid_ = threadIdx.x; asm volatile("" : "+v"(tid_));
    const int tid = tid_, wid = __builtin_amdgcn_readfirstlane(tid >> 6), lane = tid & 63, wr = wid >> 2, wc = wid & 3, fr = lane & 15, fq = lane >> 4;
    const int K = g.K, nt = K / BK;
    unsigned voffA[2], voffB[2];
#pragma unroll
    for (int i = 0; i < 2; ++i) { int R, C; stage_rc(tid * 16 + i * 8192, R, C); const int Rb = Epi::PERM ? ((R & ~31) + perm32(R & 31)) : R;
        voffA[i] = (unsigned)(R * g.lda + C) * 2u; voffB[i] = (unsigned)(Rb * g.ldb + C) * 2u; }
    const size_t kstep = (size_t)(BK * 2);
    const size_t hstepA = (size_t)HALF * g.lda * 2, hstepB = (size_t)HALF * g.ldb * 2;
    const size_t tstepA = 2 * hstepA, tstepB = 2 * hstepB, sstep = (size_t)K * 2;
    const unsigned ldsw = (unsigned)wid * 1024u;
    const int aoff = lds_byte(wr * 64 + fr, fq * 8), boff = lds_byte(wc * 32 + fr, fq * 8);
#define PG8_SA(b, h) (((b) * 2 + (h)) * HTB)
#define PG8_SB(b, h) ((4 + (b) * 2 + (h)) * HTB)
#define PG8_STAGE(bufoff, gbase, voff) do { _Pragma("unroll") for (int _i = 0; _i < 2; ++_i) \
        __builtin_amdgcn_global_load_lds((const unsigned*)((const char*)(gbase) + (voff)[_i]), (PG8_LAS unsigned*)(lds + (bufoff) + ldsw + _i * 8192), 16, 0, 0); } while (0)
#define PG8_LDA(dst, b, h) do { _Pragma("unroll") for (int m = 0; m < 4; ++m) _Pragma("unroll") for (int k = 0; k < 2; ++k) dst[m][k] = *(const PG8_LAS bf16x8*)(lds + PG8_SA(b, h) + aoff + m * 2048 + k * 1024); } while (0)
#define PG8_LDB(dst, b, h) do { _Pragma("unroll") for (int n = 0; n < 2; ++n) _Pragma("unroll") for (int k = 0; k < 2; ++k) dst[n][k] = *(const PG8_LAS bf16x8*)(lds + PG8_SB(b, h) + boff + n * 2048 + k * 1024); } while (0)
#define PG8_MMA(ai, bj, At, Bt) do { __builtin_amdgcn_s_setprio(1); _Pragma("unroll") for (int m = 0; m < 4; ++m) _Pragma("unroll") for (int n = 0; n < 2; ++n) _Pragma("unroll") for (int k = 0; k < 2; ++k) \
        acc[ai][bj][m][n] = __builtin_amdgcn_mfma_f32_16x16x32_bf16(Bt[n][k], At[m][k], acc[ai][bj][m][n], 0, 0, 0); __builtin_amdgcn_s_setprio(0); } while (0)
#define PG8_WAIT_V(n) asm volatile("s_waitcnt vmcnt(" #n ")" ::: "memory")
#define PG8_WAIT_L(n) asm volatile("s_waitcnt lgkmcnt(" #n ")" ::: "memory")
#define PG8_BAR __builtin_amdgcn_s_barrier()
#define PG8_SCHED __builtin_amdgcn_sched_barrier(0)
    Unit cur, nxt; int ui = 0;
    if (!S.next(0, cur)) return;
    f32x4 acc[2][2][4][2];
#pragma unroll
    for (int a = 0; a < 2; ++a)
#pragma unroll
        for (int b = 0; b < 2; ++b)
#pragma unroll
            for (int m = 0; m < 4; ++m)
#pragma unroll
                for (int n = 0; n < 2; ++n) acc[a][b][m][n] = (f32x4){0.f, 0.f, 0.f, 0.f};
    bf16x8 At[4][2], B0[2][2], B1[2][2];
    const char* cA = (const char*)g.A + (size_t)cur.pm * tstepA + (size_t)cur.sub * sstep; const char* cB = (const char*)g.Bt + (size_t)cur.pn * tstepB + (size_t)cur.sub * sstep;
    PG8_STAGE(PG8_SB(0, 0), cB, voffB); PG8_STAGE(PG8_SB(0, 1), cB + hstepB, voffB); PG8_STAGE(PG8_SA(0, 0), cA, voffA); PG8_STAGE(PG8_SA(0, 1), cA + hstepA, voffA);
    if (wr == 1) PG8_BAR;
    PG8_WAIT_V(2); PG8_BAR;
    PG8_STAGE(PG8_SB(1, 0), cB + kstep, voffB); PG8_STAGE(PG8_SA(1, 0), cA + kstep, voffA); PG8_STAGE(PG8_SB(1, 1), cB + hstepB + kstep, voffB);
    PG8_WAIT_V(6); PG8_BAR;
    for (;;) {
        const bool has_next = S.next(ui + 1, nxt);
        const char* nA = has_next ? (const char*)g.A + (size_t)nxt.pm * tstepA + (size_t)nxt.sub * sstep : cA; const char* nB = has_next ? (const char*)g.Bt + (size_t)nxt.pn * tstepB + (size_t)nxt.sub * sstep : cB;
        for (int t = 0; t < nt; t += 2) {
            const bool last = (t == nt - 2);
            const char* a1 = cA + (size_t)(t + 1) * kstep;
            const char* a2 = last ? nA : cA + (size_t)(t + 2) * kstep; const char* b2 = last ? nB : cB + (size_t)(t + 2) * kstep;
            const char* a3 = a2 + kstep; const char* b3 = b2 + kstep;
            PG8_LDB(B0, 0, 0); PG8_LDB(B1, 0, 1); PG8_SCHED; PG8_LDA(At, 0, 0); PG8_STAGE(PG8_SA(1, 1), a1 + hstepA, voffA);
            PG8_WAIT_V(8); PG8_WAIT_L(0); PG8_BAR; PG8_MMA(0, 0, At, B0); PG8_MMA(0, 1, At, B1); PG8_BAR; PG8_SCHED;
            PG8_LDA(At, 0, 1); PG8_STAGE(PG8_SB(0, 0), b2, voffB); PG8_STAGE(PG8_SB(0, 1), b2 + hstepB, voffB); PG8_STAGE(PG8_SA(0, 0), a2, voffA);
            PG8_WAIT_V(8); PG8_WAIT_L(0); PG8_BAR; PG8_MMA(1, 0, At, B0); PG8_MMA(1, 1, At, B1); PG8_BAR; PG8_SCHED;
            PG8_LDB(B0, 1, 0); PG8_LDB(B1, 1, 1); PG8_SCHED; PG8_LDA(At, 1, 0); PG8_STAGE(PG8_SA(0, 1), a2 + hstepA, voffA);
            PG8_WAIT_V(8); PG8_WAIT_L(0); PG8_BAR; PG8_MMA(0, 0, At, B0); PG8_MMA(0, 1, At, B1); PG8_BAR; PG8_SCHED;
            PG8_LDA(At, 1, 1); PG8_STAGE(PG8_SB(1, 0), b3, voffB); PG8_STAGE(PG8_SB(1, 1), b3 + hstepB, voffB); PG8_STAGE(PG8_SA(1, 0), a3, voffA);
            PG8_WAIT_V(8); PG8_WAIT_L(0); PG8_BAR; PG8_MMA(1, 0, At, B0); PG8_MMA(1, 1, At, B1); PG8_BAR; PG8_SCHED;
        }
        if constexpr (ALIGN_EPI) { if (wr == 0) PG8_BAR; }
        bool keep = false;
        int efr = fr, efq = fq; asm volatile("" : "+v"(efr), "+v"(efq));
        if constexpr (Epi::HAS_MID) { if (cur.sub + 1 < S.nsub) { E.mid(acc, cur, wr, wc, efr, efq, xlds); keep = true; } }
        if (!keep) E.fin(acc, cur, wr, wc, efr, efq, xlds);
        if (!has_next) break;
        if (!keep) {
#pragma unroll
        for (int a = 0; a < 2; ++a)
#pragma unroll
            for (int b = 0; b < 2; ++b)
#pragma unroll
                for (int m = 0; m < 4; ++m)
#pragma unroll
                    for (int n = 0; n < 2; ++n) acc[a][b][m][n] = (f32x4){0.f, 0.f, 0.f, 0.f};
        }
        cur = nxt; cA = nA; cB = nB; ++ui;
        if constexpr (ALIGN_EPI) { if (wr == 1) PG8_BAR; }
    }
    PG8_WAIT_V(0);
    if constexpr (!ALIGN_EPI) { if (wr == 0) PG8_BAR; }
    PG8_BAR;
#undef PG8_SA
#undef PG8_SB
#undef PG8_STAGE
#undef PG8_LDA
#undef PG8_LDB
#undef PG8_MMA
#undef PG8_WAIT_V
#undef PG8_WAIT_L
#undef PG8_BAR
#undef PG8_SCHED
}
}
namespace pg8 {
struct EpiU {
    static constexpr bool PERM = true, HAS_MID = false;
    bf16_t *QA, *KVA, *QB, *KB, *VB, *GATES; const float* bias;
    __device__ __forceinline__ void mid(f32x4 (&)[2][2][4][2], const Unit&, int, int, int, int, PG8_LAS unsigned char*) const {}
    __device__ __forceinline__ void fin(f32x4 (&acc)[2][2][4][2], const Unit& u, int wr, int wc, int fr, int fq, PG8_LAS unsigned char*) const {
        const int pn = u.pn; bf16_t* base; int ldc, colt; bool sig = false;
        if (pn < 2) { base = QA; ldc = 512; colt = pn * 256; }
        else if (pn == 2) { base = KVA; ldc = 256; colt = 0; }
        else if (pn < 5) { base = QB; ldc = 512; colt = (pn - 3) * 256; }
        else if (pn == 5) { base = KB; ldc = 256; colt = 0; }
        else if (pn == 6) { base = VB; ldc = 256; colt = 0; }
        else { base = GATES; ldc = 2048; colt = (pn - 7) * 256; sig = true; }
        const int row0 = u.pm * BM + wr * 64 + fr;
        const int col0 = colt + wc * 32 + 8 * fq, bcol0 = pn * BM + wc * 32 + 8 * fq;
        f32x4 bv[2][2];
#pragma unroll
        for (int bj = 0; bj < 2; ++bj)
#pragma unroll
            for (int n = 0; n < 2; ++n) bv[bj][n] = *(const f32x4*)(bias + bcol0 + bj * HALF + 4 * n);
#pragma unroll
        for (int ai = 0; ai < 2; ++ai)
#pragma unroll
            for (int m = 0; m < 4; ++m) { bf16_t* rowp = base + (size_t)(row0 + ai * HALF + m * 16) * ldc + col0;
#pragma unroll
                for (int bj = 0; bj < 2; ++bj) { f32x4 v0 = acc[ai][bj][m][0] + bv[bj][0], v1 = acc[ai][bj][m][1] + bv[bj][1];
                    if (sig) {
#pragma unroll
                        for (int j = 0; j < 4; ++j) { v0[j] = fmaxf(__builtin_amdgcn_rcpf(1.0f + __builtin_amdgcn_exp2f(-1.4426950408889634f * v0[j])), 1e-20f);
                                                      v1[j] = fmaxf(__builtin_amdgcn_rcpf(1.0f + __builtin_amdgcn_exp2f(-1.4426950408889634f * v1[j])), 1e-20f); } }
                    u32x4 w; w.x = cvt_pk_bf16(v0[0], v0[1]); w.y = cvt_pk_bf16(v0[2], v0[3]); w.z = cvt_pk_bf16(v1[0], v1[1]); w.w = cvt_pk_bf16(v1[2], v1[3]);
                    *(u32x4*)(rowp + bj * HALF) = w; } }
    }
};

struct EpiGate {
    static constexpr bool PERM = true, HAS_MID = true;
    const bf16_t* GATES; bf16_t* OUT;
    __device__ __forceinline__ void mid(f32x4 (&acc)[2][2][4][2], const Unit& u, int wr, int wc, int fr, int fq, PG8_LAS unsigned char*) const {
        const int row0 = u.pm * BM + wr * 64 + fr, col0 = u.pn * BM + wc * 32 + 8 * fq;
#pragma unroll
        for (int ai = 0; ai < 2; ++ai)
#pragma unroll
            for (int m = 0; m < 4; ++m) { const bf16_t* gp = GATES + (size_t)(row0 + ai * HALF + m * 16) * 2048 + col0;
#pragma unroll
                for (int bj = 0; bj < 2; ++bj) { const u32x4 a = *(const u32x4*)(gp + bj * HALF), b = *(const u32x4*)(gp + 1024 + bj * HALF);
                    f32x4 r0, r1;
                    r0[0] = bflo(a.x) * __builtin_amdgcn_rcpf(bflo(b.x)); r0[1] = bfhi(a.x) * __builtin_amdgcn_rcpf(bfhi(b.x));
                    r0[2] = bflo(a.y) * __builtin_amdgcn_rcpf(bflo(b.y)); r0[3] = bfhi(a.y) * __builtin_amdgcn_rcpf(bfhi(b.y));
                    r1[0] = bflo(a.z) * __builtin_amdgcn_rcpf(bflo(b.z)); r1[1] = bfhi(a.z) * __builtin_amdgcn_rcpf(bfhi(b.z));
                    r1[2] = bflo(a.w) * __builtin_amdgcn_rcpf(bflo(b.w)); r1[3] = bfhi(a.w) * __builtin_amdgcn_rcpf(bfhi(b.w));
                    acc[ai][bj][m][0] = acc[ai][bj][m][0] * r0; acc[ai][bj][m][1] = acc[ai][bj][m][1] * r1; } }
    }
    __device__ __forceinline__ void fin(f32x4 (&acc)[2][2][4][2], const Unit& u, int wr, int wc, int fr, int fq, PG8_LAS unsigned char*) const {
        const int row0 = u.pm * BM + wr * 64 + fr, col0 = u.pn * BM + wc * 32 + 8 * fq;
#pragma unroll
        for (int ai = 0; ai < 2; ++ai)
#pragma unroll
            for (int m = 0; m < 4; ++m) { const size_t r = (size_t)(row0 + ai * HALF + m * 16); const bf16_t* gp = GATES + r * 2048 + 1024 + col0; bf16_t* op = OUT + r * 1024 + col0;
#pragma unroll
                for (int bj = 0; bj < 2; ++bj) { const u32x4 b = *(const u32x4*)(gp + bj * HALF);
                    const f32x4 v0 = acc[ai][bj][m][0], v1 = acc[ai][bj][m][1];
                    u32x4 w; w.x = cvt_pk_bf16(v0[0] * bflo(b.x), v0[1] * bfhi(b.x)); w.y = cvt_pk_bf16(v0[2] * bflo(b.y), v0[3] * bfhi(b.y));
                    w.z = cvt_pk_bf16(v1[0] * bflo(b.z), v1[1] * bfhi(b.z)); w.w = cvt_pk_bf16(v1[2] * bflo(b.w), v1[3] * bfhi(b.w));
                    *(u32x4*)(op + bj * HALF) = w; } }
    }
};

constexpr float FX_SCALE = 1099511627776.0f, FX_INV = 1.0f / 1099511627776.0f;
__device__ __forceinline__ void fx_stats(const long long* rs, unsigned row, float eps, float& mean, float& rstd) {
    const long long s = rs[2u * row], q = rs[2u * row + 1u];
    mean = (float)s * (FX_INV / 1024.0f); const float var = (float)q * (FX_INV / 1024.0f) - mean * mean; rstd = 1.0f / sqrtf(var + eps);
}
template <bool FIRST> struct EpiRes {
    static constexpr bool PERM = false, HAS_MID = false;
    const float* src; const f32x2* stat; const long long* RSin; const float* g; const float* b; float* out; long long* RSout; const float* gz; bf16_t* ZB;
    static constexpr float alpha = 1.189207115002721f;
    __device__ __forceinline__ void mid(f32x4 (&)[2][2][4][2], const Unit&, int, int, int, int, PG8_LAS unsigned char*) const {}
    __device__ __forceinline__ void fin(f32x4 (&acc)[2][2][4][2], const Unit& u, int wr, int wc, int fr, int fq, PG8_LAS unsigned char*) const {
        const int row0 = u.pm * BM + wr * 64 + fr, col0 = u.pn * BM + wc * 32 + 4 * fq;
        f32x4 gv[2][2], bv[2][2], gzv[2][2];
#pragma unroll
        for (int bj = 0; bj < 2; ++bj)
#pragma unroll
            for (int n = 0; n < 2; ++n) { gv[bj][n] = *(const f32x4*)(g + col0 + bj * HALF + n * 16) * alpha; bv[bj][n] = *(const f32x4*)(b + col0 + bj * HALF + n * 16) * alpha;
                if (FIRST) gzv[bj][n] = *(const f32x4*)(gz + col0 + bj * HALF + n * 16); }
#pragma unroll
        for (int ai = 0; ai < 2; ++ai)
#pragma unroll
            for (int m = 0; m < 4; ++m) { const size_t r = (size_t)(row0 + ai * HALF + m * 16); const size_t off = r * 1024 + col0;
                float mu, rs; if (FIRST) { const f32x2 st = stat[r]; mu = st.x; rs = st.y; } else fx_stats(RSin, (unsigned)r, 1e-5f, mu, rs);
                float ssum = 0.f, qsum = 0.f;
#pragma unroll
                for (int bj = 0; bj < 2; ++bj)
#pragma unroll
                    for (int n = 0; n < 2; ++n) { const f32x4 x = *(const f32x4*)(src + off + bj * HALF + n * 16);
                        const f32x4 o = ((x - mu) * rs) * gv[bj][n] + bv[bj][n] + acc[ai][bj][m][n];
                        *(f32x4*)(out + off + bj * HALF + n * 16) = o;
                        ssum += (o[0] + o[1]) + (o[2] + o[3]); qsum += (o[0] * o[0] + o[1] * o[1]) + (o[2] * o[2] + o[3] * o[3]);
                        if (FIRST) { const f32x4 zb = o * gzv[bj][n]; u32x2 w; w.x = cvt_pk_bf16(zb[0], zb[1]); w.y = cvt_pk_bf16(zb[2], zb[3]); *(u32x2*)(ZB + off + bj * HALF + n * 16) = w; } }
                ssum += __shfl_xor(ssum, 16); ssum += __shfl_xor(ssum, 32); qsum += __shfl_xor(qsum, 16); qsum += __shfl_xor(qsum, 32);
                if (fq == 0) { atomicAdd((unsigned long long*)RSout + 2 * r, (unsigned long long)__float2ll_rn(ssum * FX_SCALE)); atomicAdd((unsigned long long*)RSout + 2 * r + 1, (unsigned long long)__float2ll_rn(qsum * FX_SCALE)); }
                if (m & 1) asm volatile("" ::: "memory"); }
    }
};

__device__ __forceinline__ float dpp_ror1(float v)  { return __builtin_bit_cast(float, __builtin_amdgcn_update_dpp(0, __builtin_bit_cast(int, v), 0x121, 0xF, 0xF, false)); }
__device__ __forceinline__ float dpp_ror15(float v) { return __builtin_bit_cast(float, __builtin_amdgcn_update_dpp(0, __builtin_bit_cast(int, v), 0x12F, 0xF, 0xF, false)); }
struct EpiFfnUp {
    static constexpr bool PERM = true, HAS_MID = false;
    bf16_t* ACT; const float* cw; const float* cb; float* Pb; float* Gb; float* Vb; const long long* RS; const float* C1; const float* C2;
    __device__ __forceinline__ void mid(f32x4 (&)[2][2][4][2], const Unit&, int, int, int, int, PG8_LAS unsigned char*) const {}
    __device__ __forceinline__ void fin(f32x4 (&acc)[2][2][4][2], const Unit& u, int wr, int wc, int fr, int fq, PG8_LAS unsigned char* xlds) const {
        constexpr int FF = 2816;
        PG8_LAS float* halo = (PG8_LAS float*)xlds;
        const int cl = wc * 32 + 8 * fq, ch0 = u.pn * HALF + cl;
        const int row0 = u.pm * BM + wr * 64 + fr;
        {
            f32x4 c1[2][2], c2[2][2];
#pragma unroll
            for (int bj = 0; bj < 2; ++bj)
#pragma unroll
                for (int n = 0; n < 2; ++n) { c1[bj][n] = *(const f32x4*)(C1 + u.pn * BM + bj * HALF + cl + 4 * n); c2[bj][n] = *(const f32x4*)(C2 + u.pn * BM + bj * HALF + cl + 4 * n); }
#pragma unroll
            for (int ai = 0; ai < 2; ++ai)
#pragma unroll
                for (int m = 0; m < 4; ++m) { float mu, rs; fx_stats(RS, (unsigned)(row0 + ai * HALF + m * 16), 1e-5f, mu, rs);
#pragma unroll
                    for (int bj = 0; bj < 2; ++bj)
#pragma unroll
                        for (int n = 0; n < 2; ++n) acc[ai][bj][m][n] = (acc[ai][bj][m][n] - c1[bj][n] * mu) * rs + c2[bj][n];
                    asm volatile("" : "+v"(acc[ai][0][m][0]), "+v"(acc[ai][0][m][1]), "+v"(acc[ai][1][m][0]), "+v"(acc[ai][1][m][1]));
                    if (m & 1) asm volatile("" ::: "memory"); }
        }
        asm volatile("" ::: "memory");
#pragma unroll
        for (int ai = 0; ai < 2; ++ai) { const int s = 2 * ai + wr;
            if (fr == 0)  { *(PG8_LAS f32x4*)(halo + (s * 2 + 0) * HALF + cl) = acc[ai][0][0][0]; *(PG8_LAS f32x4*)(halo + (s * 2 + 0) * HALF + cl + 4) = acc[ai][0][0][1]; }
            if (fr == 15) { *(PG8_LAS f32x4*)(halo + (s * 2 + 1) * HALF + cl) = acc[ai][0][3][0]; *(PG8_LAS f32x4*)(halo + (s * 2 + 1) * HALF + cl + 4) = acc[ai][0][3][1]; } }
        f32x4 w0[2], w1[2], w2[2], cbv[2];
#pragma unroll
        for (int n = 0; n < 2; ++n) { w0[n] = *(const f32x4*)(cw + ch0 + 4 * n); w1[n] = *(const f32x4*)(cw + FF + ch0 + 4 * n); w2[n] = *(const f32x4*)(cw + 2 * FF + ch0 + 4 * n); cbv[n] = *(const f32x4*)(cb + ch0 + 4 * n); }
        asm volatile("s_waitcnt lgkmcnt(0)" ::: "memory"); __builtin_amdgcn_s_barrier(); asm volatile("" ::: "memory");
#pragma unroll
        for (int ai = 0; ai < 2; ++ai) { const int s = 2 * ai + wr;
            f32x4 upsrc[2], dnh[2], Lc[2];
            if (s > 0) { upsrc[0] = *(const PG8_LAS f32x4*)(halo + ((s - 1) * 2 + 1) * HALF + cl); upsrc[1] = *(const PG8_LAS f32x4*)(halo + ((s - 1) * 2 + 1) * HALF + cl + 4); }
            else { upsrc[0] = (f32x4){0.f, 0.f, 0.f, 0.f}; upsrc[1] = upsrc[0]; }
            if (s < 3) { dnh[0] = *(const PG8_LAS f32x4*)(halo + ((s + 1) * 2 + 0) * HALF + cl); dnh[1] = *(const PG8_LAS f32x4*)(halo + ((s + 1) * 2 + 0) * HALF + cl + 4); }
            else { dnh[0] = (f32x4){0.f, 0.f, 0.f, 0.f}; dnh[1] = dnh[0]; }
#pragma unroll
            for (int n = 0; n < 2; ++n)
#pragma unroll
                for (int j = 0; j < 4; ++j) Lc[n][j] = dpp_ror15(acc[ai][0][0][n][j]);
#pragma unroll
            for (int m = 0; m < 4; ++m) {
                f32x4 cv[2];
#pragma unroll
                for (int n = 0; n < 2; ++n)
#pragma unroll
                    for (int j = 0; j < 4; ++j) {
                        const float gc = acc[ai][0][m][n][j];
                        const float R = dpp_ror1(gc);
                        const float Ln = (m < 3) ? dpp_ror15(acc[ai][0][m < 3 ? m + 1 : 3][n][j]) : dnh[n][j];
                        const float up = (fr == 0) ? upsrc[n][j] : R;
                        const float dn = (fr == 15) ? Ln : Lc[n][j];
                        upsrc[n][j] = R; Lc[n][j] = Ln;
                        cv[n][j] = w0[n][j] * up + w1[n][j] * gc + w2[n][j] * dn + cbv[n][j];
                    }
                const unsigned r = (unsigned)(row0 + ai * HALF + m * 16);
                if ((ai == 0 && m == 0) || (ai == 1 && m == 3)) {
                    const bool first = (ai == 0 && m == 0);
                    if (first ? (wr == 0 && fr == 0) : (wr == 1 && fr == 15)) {
                        const size_t bo = ((size_t)u.pm * 2 + (first ? 0 : 1)) * FF + ch0;
#pragma unroll
                        for (int n = 0; n < 2; ++n) { *(f32x4*)(Pb + bo + 4 * n) = cv[n]; *(f32x4*)(Gb + bo + 4 * n) = acc[ai][0][m][n]; *(f32x4*)(Vb + bo + 4 * n) = acc[ai][1][m][n]; }
                    }
                }
                f32x4 o[2];
#pragma unroll
                for (int n = 0; n < 2; ++n) { const f32x2 a = gelu_pk((f32x2){cv[n][0], cv[n][1]}), b = gelu_pk((f32x2){cv[n][2], cv[n][3]});
                    o[n] = (f32x4){a.x, a.y, b.x, b.y} * acc[ai][1][m][n]; }
                u32x4 w; w.x = cvt_pk_bf16(o[0][0], o[0][1]); w.y = cvt_pk_bf16(o[0][2], o[0][3]); w.z = cvt_pk_bf16(o[1][0], o[1][1]); w.w = cvt_pk_bf16(o[1][2], o[1][3]);
                *(u32x4*)(ACT + (unsigned)(r * (unsigned)FF + (unsigned)ch0)) = w;
            }
        }
    }
};
}
namespace attn {
using bf16x8 = __attribute__((ext_vector_type(8))) short;
using s16x4  = __attribute__((ext_vector_type(4))) short;
using f32x16 = __attribute__((ext_vector_type(16))) float;
using u32x4  = __attribute__((ext_vector_type(4))) unsigned;
typedef unsigned short bf16_t;
constexpr int NW = 8, QBLK = 32, KVBLK = 64;
#define KSWZ(row, colB) ((row) * 256 + ((colB) ^ (((row) & 7) << 4)))
#define SBAR() __builtin_amdgcn_sched_barrier(0)
__device__ __forceinline__ int crow(int r, int hi) { return (r & 3) + 8 * (r >> 2) + 4 * hi; }
__device__ __forceinline__ unsigned cvtpk(float lo, float hi) { unsigned r; asm volatile("v_cvt_pk_bf16_f32 %0, %1, %2" : "=v"(r) : "v"(lo), "v"(hi)); return r; }
__device__ __forceinline__ unsigned short f2bf_s(float f) { unsigned u = __float_as_uint(f); return (unsigned short)((u + 0x7fffu + ((u >> 16) & 1u)) >> 16); }
template <int OFF> __device__ __forceinline__ s16x4 tr_read(int vb) { s16x4 r; asm volatile("ds_read_b64_tr_b16 %0, %1 offset:%2" : "=&v"(r) : "v"(vb), "i"(OFF) : "memory"); return r; }
__device__ __forceinline__ int v_rd_base(int lane) { return ((lane & 3) << 3) | (((lane >> 2) & 3) << 6) | (((lane >> 4) & 1) << 5) | (((lane >> 5) & 1) << 8); }
#define PK4(P, BASE, OUT) do { unsigned a0 = cvtpk(P[BASE + 0], P[BASE + 1]), a1 = cvtpk(P[BASE + 2], P[BASE + 3]);   \
    unsigned b0 = cvtpk(P[BASE + 4], P[BASE + 5]), b1 = cvtpk(P[BASE + 6], P[BASE + 7]);                              \
    auto r0 = __builtin_amdgcn_permlane32_swap(a0, b0, false, false); auto r1 = __builtin_amdgcn_permlane32_swap(a1, b1, false, false); \
    u32x4 w = {r0[0], r1[0], r0[1], r1[1]}; OUT = *reinterpret_cast<bf16x8*>(&w); } while (0)
#define PKF(L, H) (bf16x8){L[0], L[1], L[2], L[3], H[0], H[1], H[2], H[3]}

namespace dense {
constexpr int D = 128;
constexpr float SCALE = 0.088388347648318440f;
constexpr float THR = 8.f;
constexpr int LDQ = 512, LDK = 256, LDO = 1024;
constexpr size_t SHM_V = KVBLK * D * 2, SHM_K = KVBLK * D * 2, SHM_ATTN = 2 * SHM_V + 2 * SHM_K + NW * 64 * 4;
__device__ __forceinline__ void partialSM(f32x16& p0, f32x16& p1, float& m_reg, float& mn, float& alpha) {
  constexpr float C = SCALE * 1.4426950408889634f;
  float pmax = p0[0]; for (int r = 1; r < 16; ++r) pmax = fmaxf(pmax, p0[r]); for (int r = 0; r < 16; ++r) pmax = fmaxf(pmax, p1[r]);
  { auto rr = __builtin_amdgcn_permlane32_swap(__float_as_uint(pmax), __float_as_uint(pmax), false, false);
    pmax = fmaxf(__uint_as_float(rr[0]), __uint_as_float(rr[1])); }
  if (__builtin_expect(__all(pmax - m_reg <= THR / SCALE), 1)) { mn = m_reg; alpha = 1.f; }
  else { mn = fmaxf(m_reg, pmax); alpha = __builtin_amdgcn_exp2f((m_reg - mn) * C); m_reg = mn; }
  float mnC = -mn * C;
  for (int r = 0; r < 16; ++r) p0[r] = fmaf(p0[r], C, mnC); for (int r = 0; r < 16; ++r) p1[r] = fmaf(p1[r], C, mnC);
  for (int r = 0; r < 16; ++r) p0[r] = __builtin_amdgcn_exp2f(p0[r]);
}
__device__ __forceinline__ void finishSM(f32x16& p0, f32x16& p1, float alpha, float& l_reg, bf16x8& pa0, bf16x8& pa1, bf16x8& pa2, bf16x8& pa3) {
  for (int r = 0; r < 16; ++r) p1[r] = __builtin_amdgcn_exp2f(p1[r]);
  float ps = 0; for (int r = 0; r < 16; ++r) ps += p0[r]; for (int r = 0; r < 16; ++r) ps += p1[r];
  { auto rr = __builtin_amdgcn_permlane32_swap(__float_as_uint(ps), __float_as_uint(ps), false, false);
    ps = __uint_as_float(rr[0]) + __uint_as_float(rr[1]); }
  l_reg = l_reg * alpha + ps;
  PK4(p0, 0, pa0); PK4(p0, 8, pa1); PK4(p1, 0, pa2); PK4(p1, 8, pa3);
}
__device__ __forceinline__ void qkt(f32x16& p0, f32x16& p1, const bf16_t* Ks, const bf16x8* qr, int r32, int hi) {
  p0 = f32x16{}; p1 = f32x16{};
  for (int d0 = 0; d0 < 8; ++d0) { int cb = (d0 * 16 + hi * 8) * 2;
    bf16x8 b0 = *reinterpret_cast<const bf16x8*>((const char*)Ks + KSWZ(r32, cb));
    bf16x8 b1 = *reinterpret_cast<const bf16x8*>((const char*)Ks + KSWZ(32 + r32, cb));
    p0 = __builtin_amdgcn_mfma_f32_32x32x16_bf16(b0, qr[d0], p0, 0, 0, 0);
    p1 = __builtin_amdgcn_mfma_f32_32x32x16_bf16(b1, qr[d0], p1, 0, 0, 0); }
}
__device__ __forceinline__ int v_st(int k, int c) { const int kk = (k & ~0xC) | ((k & 4) << 1) | ((k & 8) >> 1); return ((kk >> 3) * 4 + (c >> 5)) * 512 + ((kk & 7) * 32 + (c & 31)) * 2; }
constexpr int v_rd_off(int d0, int ks, int half) { return d0 * 512 + ks * 4096 + half * 2048; }
template <int D0> __device__ __forceinline__ void pv_one(f32x16& od, int vb, bf16x8 pa0, bf16x8 pa1, bf16x8 pa2, bf16x8 pa3) {
  const s16x4 l0 = tr_read<v_rd_off(D0, 0, 0)>(vb), h0 = tr_read<v_rd_off(D0, 0, 1)>(vb), l1 = tr_read<v_rd_off(D0, 1, 0)>(vb), h1 = tr_read<v_rd_off(D0, 1, 1)>(vb);
  const s16x4 l2 = tr_read<v_rd_off(D0, 2, 0)>(vb), h2 = tr_read<v_rd_off(D0, 2, 1)>(vb), l3 = tr_read<v_rd_off(D0, 3, 0)>(vb), h3 = tr_read<v_rd_off(D0, 3, 1)>(vb);
  asm volatile("s_waitcnt lgkmcnt(0)" ::: "memory"); SBAR();
  od = __builtin_amdgcn_mfma_f32_32x32x16_bf16(pa0, PKF(l0, h0), od, 0, 0, 0);
  od = __builtin_amdgcn_mfma_f32_32x32x16_bf16(pa1, PKF(l1, h1), od, 0, 0, 0);
  od = __builtin_amdgcn_mfma_f32_32x32x16_bf16(pa2, PKF(l2, h2), od, 0, 0, 0);
  od = __builtin_amdgcn_mfma_f32_32x32x16_bf16(pa3, PKF(l3, h3), od, 0, 0, 0);
}
__device__ __forceinline__ void pv_d0(f32x16* o, int vb, bf16x8 pa0, bf16x8 pa1, bf16x8 pa2, bf16x8 pa3) {
  pv_one<0>(o[0], vb, pa0, pa1, pa2, pa3); pv_one<1>(o[1], vb, pa0, pa1, pa2, pa3); pv_one<2>(o[2], vb, pa0, pa1, pa2, pa3); pv_one<3>(o[3], vb, pa0, pa1, pa2, pa3);
}
__device__ __forceinline__ void body(const bf16_t* __restrict__ Qb, const bf16_t* __restrict__ Kh, const bf16_t* __restrict__ Vh, bf16_t* __restrict__ Ob, int seq, char* lds) {
  int tid_ = threadIdx.x; asm volatile("" : "+v"(tid_));
  const int tid = tid_, wid = tid >> 6, lane = tid & 63, r32 = lane & 31, hi = lane >> 5;
  bf16_t* V_lds = (bf16_t*)lds; bf16_t* K_lds = (bf16_t*)(lds + 2 * SHM_V);
  float* ws = (float*)(lds + 2 * SHM_V + 2 * SHM_K) + wid * 64; float* li_l = ws; float* al_l = ws + 32;
  float m_reg = -1e30f, l_reg = 0; f32x16 o[4] = {}; bf16x8 qr[8];
  const bf16_t* Qw = Qb + (long)(wid * QBLK + r32) * LDQ + hi * 8;
#pragma unroll
  for (int d0 = 0; d0 < 8; ++d0) qr[d0] = *reinterpret_cast<const bf16x8*>(Qw + d0 * 16);
  const int sr = tid >> 4, sc = (tid & 15) * 8, vst0 = v_st(sr, sc), vst1 = v_st(32 + sr, sc);
  const int vb0 = (int)(uintptr_t)V_lds + v_rd_base(lane);
  struct { bf16x8 vs0, vs1, ks0, ks1; } sr_[2];
#define SLOAD(i, k0) do { sr_[i].vs0 = *reinterpret_cast<const bf16x8*>(&Vh[(long)((k0) + sr) * LDK + sc]); sr_[i].vs1 = *reinterpret_cast<const bf16x8*>(&Vh[(long)((k0) + 32 + sr) * LDK + sc]); \
    sr_[i].ks0 = *reinterpret_cast<const bf16x8*>(&Kh[(long)((k0) + sr) * LDK + sc]); sr_[i].ks1 = *reinterpret_cast<const bf16x8*>(&Kh[(long)((k0) + 32 + sr) * LDK + sc]); } while (0)
#define SWRITE(b, i) do { *(bf16x8*)((char*)V_lds + (b) * SHM_V + vst0) = sr_[i].vs0;          \
    *(bf16x8*)((char*)V_lds + (b) * SHM_V + vst1) = sr_[i].vs1; int kc = sc * 2;               \
    *(bf16x8*)((char*)K_lds + (b) * SHM_K + KSWZ(sr, kc)) = sr_[i].ks0;                       \
    *(bf16x8*)((char*)K_lds + (b) * SHM_K + KSWZ(32 + sr, kc)) = sr_[i].ks1; } while (0)
#define SWAIT() asm volatile("s_waitcnt vmcnt(4)" ::: "memory")
#define RESC(a) do { if (__any((a) < 1.f)) { if (hi == 0) al_l[r32] = (a); asm volatile("s_waitcnt lgkmcnt(0)" ::: "memory"); \
    for (int d = 0; d < 4; ++d) for (int r = 0; r < 16; ++r) o[d][r] *= al_l[crow(r, hi)]; } } while (0)
  f32x16 pA0, pA1, pB0, pB1; float mnA, mnB, alA, alB; bf16x8 pa0, pa1, pa2, pa3; const int NT = seq / KVBLK;
  constexpr int SE = 0, SO = 1;
  SLOAD(SE, 0); asm volatile("s_waitcnt vmcnt(0)" ::: "memory"); SWRITE(0, SE); __syncthreads();
  qkt(pA0, pA1, K_lds, qr, r32, hi); partialSM(pA0, pA1, m_reg, mnA, alA);
  SLOAD(SO, KVBLK); if (2 < NT) SLOAD(SE, 2 * KVBLK);
  SWAIT(); SWRITE(1, SO); __syncthreads();
  for (int j = 1; j + 1 < NT; j += 2) {
    SBAR(); qkt(pB0, pB1, (bf16_t*)((char*)K_lds + SHM_K), qr, r32, hi);
    finishSM(pA0, pA1, alA, l_reg, pa0, pa1, pa2, pa3); SBAR();
    SLOAD(SO, (j + 2) * KVBLK); SBAR();
    pv_d0(o, vb0, pa0, pa1, pa2, pa3); partialSM(pB0, pB1, m_reg, mnB, alB);
    __syncthreads(); SWAIT(); SWRITE(0, SE);
    RESC(alB); __syncthreads();
    SBAR(); qkt(pA0, pA1, K_lds, qr, r32, hi);
    finishSM(pB0, pB1, alB, l_reg, pa0, pa1, pa2, pa3); SBAR();
    if (j + 3 < NT) SLOAD(SE, (j + 3) * KVBLK); SBAR();
    pv_d0(o, vb0 + (int)SHM_V, pa0, pa1, pa2, pa3); partialSM(pA0, pA1, m_reg, mnA, alA);
    __syncthreads(); SWAIT(); SWRITE(1, SO);
    RESC(alA); __syncthreads();
  }
  SBAR(); qkt(pB0, pB1, (bf16_t*)((char*)K_lds + SHM_K), qr, r32, hi);
  finishSM(pA0, pA1, alA, l_reg, pa0, pa1, pa2, pa3); SBAR();
  pv_d0(o, vb0, pa0, pa1, pa2, pa3); partialSM(pB0, pB1, m_reg, mnB, alB);
  __syncthreads(); RESC(alB);
  finishSM(pB0, pB1, alB, l_reg, pa0, pa1, pa2, pa3); SBAR();
  pv_d0(o, vb0 + (int)SHM_V, pa0, pa1, pa2, pa3);
  if (hi == 0) li_l[r32] = l_reg; asm volatile("s_waitcnt lgkmcnt(0)" ::: "memory");
  float rli[16];
#pragma unroll
  for (int r = 0; r < 16; ++r) rli[r] = __builtin_amdgcn_rcpf(li_l[crow(r, hi)]);
  bf16_t* Ow = Ob + (long)(wid * QBLK) * LDO;
#pragma unroll
  for (int r = 0; r < 16; ++r) { int orow = crow(r, hi);
    for (int d0 = 0; d0 < 4; ++d0) Ow[(long)orow * LDO + d0 * 32 + r32] = f2bf_s(o[d0][r] * rli[r]); }
#undef SLOAD
#undef SWRITE
#undef SWAIT
#undef RESC
}
}

namespace win {
constexpr int D = 64, BAND = 320, NTILE = 5;
constexpr int LDS_K = 0, LDS_V = BAND * D * 2, LDS_WS = 2 * BAND * D * 2, LDS_BYTES = LDS_WS + NW * 64 * 4;
#define KSWZ64(row, colB) ((row) * 128 + ((colB) ^ ((((row) >> 1) & 7) << 4)))
__device__ __forceinline__ int v_st64(int k, int c) { const int kk = (k & ~0xC) | ((k & 4) << 1) | ((k & 8) >> 1); return ((kk >> 3) * 2 + (c >> 5)) * 512 + ((kk & 7) * 32 + (c & 31)) * 2; }
constexpr int v_rd_off64(int d0, int ks, int half) { return d0 * 512 + ks * 2048 + half * 1024; }
template <int D0> __device__ __forceinline__ void pv_one64(f32x16& od, int vb, bf16x8 pa0, bf16x8 pa1, bf16x8 pa2, bf16x8 pa3) {
  const s16x4 l0 = tr_read<v_rd_off64(D0, 0, 0)>(vb), h0 = tr_read<v_rd_off64(D0, 0, 1)>(vb), l1 = tr_read<v_rd_off64(D0, 1, 0)>(vb), h1 = tr_read<v_rd_off64(D0, 1, 1)>(vb);
  const s16x4 l2 = tr_read<v_rd_off64(D0, 2, 0)>(vb), h2 = tr_read<v_rd_off64(D0, 2, 1)>(vb), l3 = tr_read<v_rd_off64(D0, 3, 0)>(vb), h3 = tr_read<v_rd_off64(D0, 3, 1)>(vb);
  asm volatile("s_waitcnt lgkmcnt(0)" ::: "memory"); SBAR();
  od = __builtin_amdgcn_mfma_f32_32x32x16_bf16(pa0, PKF(l0, h0), od, 0, 0, 0);
  od = __builtin_amdgcn_mfma_f32_32x32x16_bf16(pa1, PKF(l1, h1), od, 0, 0, 0);
  od = __builtin_amdgcn_mfma_f32_32x32x16_bf16(pa2, PKF(l2, h2), od, 0, 0, 0);
  od = __builtin_amdgcn_mfma_f32_32x32x16_bf16(pa3, PKF(l3, h3), od, 0, 0, 0);
}
__device__ __forceinline__ void tile(const bool MASKED, int jt, const char* K_lds, int vb0, const bf16x8 (&qr)[4], f32x16 (&o)[2], float& m_reg, float& l_reg, float* al_l,
                                     int q0, int qp, float dq, float slope2, int r32, int hi) {
  constexpr int SEQ = 4096;
  constexpr float C1 = 0.125f * 1.4426950408889634f;
  SBAR();
  f32x16 p0 = f32x16{}, p1 = f32x16{};
  const char* Kt = K_lds + jt * 8192;
#pragma unroll
  for (int d0 = 0; d0 < 4; ++d0) { const int cb = (d0 * 16 + hi * 8) * 2;
    bf16x8 b0 = *reinterpret_cast<const bf16x8*>(Kt + KSWZ64(r32, cb));
    bf16x8 b1 = *reinterpret_cast<const bf16x8*>(Kt + KSWZ64(32 + r32, cb));
    p0 = __builtin_amdgcn_mfma_f32_32x32x16_bf16(b0, qr[d0], p0, 0, 0, 0);
    p1 = __builtin_amdgcn_mfma_f32_32x32x16_bf16(b1, qr[d0], p1, 0, 0, 0); }
  const float dt = dq - 64.0f * (float)jt;
  float pmax = -1e30f;
  if (MASKED) {
    const int kbase = q0 - 128 + jt * 64;
#pragma unroll
    for (int r = 0; r < 16; ++r) {
      const int k0 = kbase + crow(r, hi), k1 = k0 + 32;
      const float d0f = fabsf(dt - (float)((r & 3) + 8 * (r >> 2))), d1f = fabsf(dt - (float)((r & 3) + 8 * (r >> 2) + 32));
      const bool v0 = (d0f <= 128.0f) && (k0 >= 0) && (k0 < SEQ), v1 = (d1f <= 128.0f) && (k1 >= 0) && (k1 < SEQ);
      p0[r] = v0 ? fmaf(p0[r], C1, -slope2 * d0f) : -1e30f;
      p1[r] = v1 ? fmaf(p1[r], C1, -slope2 * d1f) : -1e30f;
      pmax = fmaxf(pmax, fmaxf(p0[r], p1[r]));
    }
  } else {
#pragma unroll
    for (int r = 0; r < 16; ++r) {
      const float d0f = fabsf(dt - (float)((r & 3) + 8 * (r >> 2))), d1f = fabsf(dt - (float)((r & 3) + 8 * (r >> 2) + 32));
      p0[r] = fmaf(p0[r], C1, -slope2 * d0f);
      p1[r] = fmaf(p1[r], C1, -slope2 * d1f);
      pmax = fmaxf(pmax, fmaxf(p0[r], p1[r]));
    }
  }
  { auto rr = __builtin_amdgcn_permlane32_swap(__float_as_uint(pmax), __float_as_uint(pmax), false, false);
    pmax = fmaxf(__uint_as_float(rr[0]), __uint_as_float(rr[1])); }
  const float mn = fmaxf(m_reg, pmax), alpha = __builtin_amdgcn_exp2f(m_reg - mn); m_reg = mn;
  float ps = 0.f;
#pragma unroll
  for (int r = 0; r < 16; ++r) { p0[r] = __builtin_amdgcn_exp2f(p0[r] - mn); p1[r] = __builtin_amdgcn_exp2f(p1[r] - mn); ps += p0[r] + p1[r]; }
  { auto rr = __builtin_amdgcn_permlane32_swap(__float_as_uint(ps), __float_as_uint(ps), false, false);
    ps = __uint_as_float(rr[0]) + __uint_as_float(rr[1]); }
  l_reg = l_reg * alpha + ps;
  if (__any(alpha < 1.f)) { if (hi == 0) al_l[r32] = alpha; asm volatile("s_waitcnt lgkmcnt(0)" ::: "memory");
#pragma unroll
    for (int r = 0; r < 16; ++r) { const float a = al_l[crow(r, hi)]; o[0][r] *= a; o[1][r] *= a; } }
  bf16x8 pa0, pa1, pa2, pa3;
  PK4(p0, 0, pa0); PK4(p0, 8, pa1); PK4(p1, 0, pa2); PK4(p1, 8, pa3);
  const int vb = vb0 + jt * 8192;
  pv_one64<0>(o[0], vb, pa0, pa1, pa2, pa3); pv_one64<1>(o[1], vb, pa0, pa1, pa2, pa3);
  SBAR();
}
struct Band { bf16x8 k[5], v[5]; };
__device__ __forceinline__ void band_load(Band& B, const bf16_t* __restrict__ KVA, int b, int kvh, int q0, int tid) {
  constexpr int SEQ = 4096;
#pragma unroll
  for (int j = 0; j < 5; ++j) { const int c = tid + 512 * j, key = c >> 3, ch = c & 7; int kp = q0 - 128 + key; kp = kp < 0 ? 0 : (kp > SEQ - 1 ? SEQ - 1 : kp);
    const bf16_t* src = KVA + ((long)b * SEQ + kp) * 256 + kvh * 64 + ch * 8;
    B.k[j] = *reinterpret_cast<const bf16x8*>(src); B.v[j] = *reinterpret_cast<const bf16x8*>(src + 128); }
}
__device__ __forceinline__ void band_store(const Band& B, char* K_lds, char* V_lds, int tid) {
#pragma unroll
  for (int j = 0; j < 5; ++j) { const int c = tid + 512 * j, key = c >> 3, ch = c & 7;
    *(bf16x8*)(K_lds + KSWZ64(key, ch * 16)) = B.k[j];
    *(bf16x8*)(V_lds + (key >> 6) * 8192 + v_st64(key & 63, ch * 8)) = B.v[j]; }
}
__device__ __forceinline__ void run(const bf16_t* __restrict__ QA, const bf16_t* __restrict__ KVA, bf16_t* __restrict__ OAB, const float* __restrict__ sinks, int u0, int ustep, int nunits, char* lds) {
  constexpr int SEQ = 4096;
  constexpr float LOG2E = 1.4426950408889634f;
  int tid_ = threadIdx.x; asm volatile("" : "+v"(tid_));
  const int tid = tid_, wid = tid >> 6, lane = tid & 63, r32 = lane & 31, hi = lane >> 5;
  char* K_lds = lds + LDS_K; char* V_lds = lds + LDS_V;
  float* ws = (float*)(lds + LDS_WS) + wid * 64; float* li_l = ws; float* al_l = ws + 32;
  const int vb0 = (int)(uintptr_t)V_lds + v_rd_base(lane);
  if (u0 >= nunits) return;
  Band B; band_load(B, KVA, u0 >> 7, (u0 >> 6) & 1, (u0 & 63) * 64, tid);
  for (int u = u0; u < nunits; u += ustep) {
    const int q0 = (u & 63) * 64, kvh = (u >> 6) & 1, b = u >> 7;
    const long rowbase = (long)b * SEQ;
    band_store(B, K_lds, V_lds, tid);
    const int un = u + ustep;
    if (un < nunits) band_load(B, KVA, un >> 7, (un >> 6) & 1, (un & 63) * 64, tid);
    const int g = wid & 3, rb = wid >> 2, h = kvh * 4 + g;
    const int qrow0 = q0 + 32 * rb;
    bf16x8 qr[4];
    { const bf16_t* Qw = QA + (rowbase + qrow0 + r32) * 512 + h * 64 + hi * 8;
#pragma unroll
      for (int d0 = 0; d0 < 4; ++d0) qr[d0] = *reinterpret_cast<const bf16x8*>(Qw + d0 * 16); }
    const float slope2 = __builtin_amdgcn_exp2f(-(float)(h + 1)) * LOG2E;
    float m_reg = sinks[h] * LOG2E, l_reg = 1.0f;
    f32x16 o[2] = {};
    const int qp = qrow0 + r32;
    const float dq = (float)(qp - (q0 - 128) - 4 * hi);
    __syncthreads();
    const bool edge = (q0 < 128) || (q0 + 192 > SEQ);
#pragma unroll 1
    for (int i = 0; i < NTILE; ++i) { const int jt = 2 + ((i & 1) ? -((i + 1) >> 1) : ((i + 1) >> 1));
      tile(edge || i >= 3, jt, K_lds, vb0, qr, o, m_reg, l_reg, al_l, q0, qp, dq, slope2, r32, hi); }
    if (hi == 0) li_l[r32] = l_reg; asm volatile("s_waitcnt lgkmcnt(0)" ::: "memory");
    bf16_t* Ow = OAB + (rowbase + qrow0) * 1024 + h * 64;
#pragma unroll
    for (int r = 0; r < 16; ++r) { const int orow = crow(r, hi); const float rl = __builtin_amdgcn_rcpf(li_l[orow]);
#pragma unroll
      for (int d0 = 0; d0 < 2; ++d0) Ow[(long)orow * 1024 + d0 * 32 + r32] = f2bf_s(o[d0][r] * rl); }
    __syncthreads();
  }
}
}
#undef KSWZ
#undef KSWZ64
#undef SBAR
#undef PK4
#undef PKF
}
constexpr int NWAVES = 8;
constexpr int BATCH = 8, SEQ = 4096, DM = 1024, M = BATCH * SEQ;
constexpr int NIN = 3840, DFF = 2816, NGV = 2 * DFF;
constexpr float LN_EPS = 1e-5f, RMS_EPS = 1e-6f;
constexpr float ALPHA = 1.189207115002721f;

constexpr size_t MiB = 1u << 20;
constexpr size_t WS_CTL = 0, CTL_ZERO_BYTES = 1 * MiB;
constexpr size_t WS_WIN = 2 * MiB;
constexpr size_t WS_WOAB = 10 * MiB;
constexpr size_t WS_WOUT = 12 * MiB;
constexpr size_t WS_WGV = 14 * MiB;
constexpr size_t WS_WD = 25 * MiB;
constexpr size_t WS_PB = 31 * MiB, WS_GB = 34 * MiB, WS_VBND = 37 * MiB;
constexpr size_t WS_STAT0 = 40 * MiB, WS_STAT1 = 41 * MiB;
constexpr size_t WS_RS1 = 43 * MiB, WS_RS2 = 44 * MiB;
constexpr size_t WS_C1 = 45 * MiB, WS_C2 = 45 * MiB + 65536;
constexpr size_t WS_ROPE = 42 * MiB;
constexpr size_t WS_H0B = 48 * MiB;
constexpr size_t WS_QA = 112 * MiB;
constexpr size_t WS_KVA = 144 * MiB;
constexpr size_t WS_QB = 160 * MiB;
constexpr size_t WS_KB = 192 * MiB;
constexpr size_t WS_VB = 208 * MiB;
constexpr size_t WS_GATES = 224 * MiB;
constexpr size_t WS_OAB = 352 * MiB;
constexpr size_t WS_MERGED = 416 * MiB;
constexpr size_t WS_ACT = 112 * MiB;
constexpr size_t WS_END = 480 * MiB;
static_assert(WS_ACT + (size_t)M * DFF * 2 <= WS_OAB, "act overlay");

constexpr int CW_BAR = 4096;
constexpr int CW_ERR = 64;
constexpr int RING_BYTES = 131072, XLDS_OFF = RING_BYTES, MISC_OFF = RING_BYTES + 8192, LDS_BYTES = 147456;

#define GAS __attribute__((address_space(1)))
#define LAS __attribute__((address_space(3)))
typedef unsigned short bf16;
typedef unsigned v4u __attribute__((ext_vector_type(4)));
typedef float f32x4 __attribute__((ext_vector_type(4)));
typedef float f32x2 __attribute__((ext_vector_type(2)));
__device__ __forceinline__ unsigned f2bf(float f) { unsigned u = __builtin_bit_cast(unsigned, f); return (u + 0x7fffu + ((u >> 16) & 1u)) >> 16; }
__device__ __forceinline__ unsigned pk2(float lo, float hi) { return f2bf(lo) | (f2bf(hi) << 16); }
__device__ __forceinline__ float bf2f(unsigned short v) { return __uint_as_float((unsigned)v << 16); }

struct Args { const float* in[20]; float* out; unsigned char* ws; };
struct Frame { LAS unsigned char* lds; int tid, lane, wave, vcu, G; };
struct Ptrs {
    const float *x, *ln_in_g, *ln_in_b, *w_in, *b_in, *a_sinks, *bq_norm, *bk_norm, *w_oa, *w_ob, *w_out, *ln1_g, *ln1_b, *w_gate, *w_val, *conv_w, *conv_b, *w_down, *ln2_g, *ln2_b;
    float* out; unsigned* ctl;
    bf16 *WinT, *WoabT, *WoutT, *WgvT, *WdT, *H0B, *QA, *KVA, *QB, *KB, *VB, *GATES, *OAB, *MERGED, *ACT;
    float *Pb, *Gb, *Vbnd, *ROPE, *C1, *C2; f32x2 *STAT0, *STAT1; long long *RS1, *RS2;
};
__device__ __forceinline__ Ptrs get_ptrs() {
    const __attribute__((address_space(4))) Args* a = (const __attribute__((address_space(4))) Args*)__builtin_amdgcn_kernarg_segment_ptr(); asm volatile("" : "+s"(a));
    Ptrs P; unsigned char* ws = a->ws;
    P.x = a->in[0]; P.ln_in_g = a->in[1]; P.ln_in_b = a->in[2]; P.w_in = a->in[3]; P.b_in = a->in[4]; P.a_sinks = a->in[5]; P.bq_norm = a->in[6]; P.bk_norm = a->in[7];
    P.w_oa = a->in[8]; P.w_ob = a->in[9]; P.w_out = a->in[10]; P.ln1_g = a->in[11]; P.ln1_b = a->in[12]; P.w_gate = a->in[13]; P.w_val = a->in[14];
    P.conv_w = a->in[15]; P.conv_b = a->in[16]; P.w_down = a->in[17]; P.ln2_g = a->in[18]; P.ln2_b = a->in[19]; P.out = a->out;
    P.ctl = (unsigned*)(ws + WS_CTL);
    P.WinT = (bf16*)(ws + WS_WIN); P.WoabT = (bf16*)(ws + WS_WOAB); P.WoutT = (bf16*)(ws + WS_WOUT); P.WgvT = (bf16*)(ws + WS_WGV); P.WdT = (bf16*)(ws + WS_WD);
    P.H0B = (bf16*)(ws + WS_H0B); P.QA = (bf16*)(ws + WS_QA); P.KVA = (bf16*)(ws + WS_KVA); P.QB = (bf16*)(ws + WS_QB); P.KB = (bf16*)(ws + WS_KB); P.VB = (bf16*)(ws + WS_VB);
    P.GATES = (bf16*)(ws + WS_GATES); P.OAB = (bf16*)(ws + WS_OAB); P.MERGED = (bf16*)(ws + WS_MERGED); P.ACT = (bf16*)(ws + WS_ACT);
    P.Pb = (float*)(ws + WS_PB); P.Gb = (float*)(ws + WS_GB); P.Vbnd = (float*)(ws + WS_VBND); P.ROPE = (float*)(ws + WS_ROPE);
    P.STAT0 = (f32x2*)(ws + WS_STAT0); P.STAT1 = (f32x2*)(ws + WS_STAT1);
    P.C1 = (float*)(ws + WS_C1); P.C2 = (float*)(ws + WS_C2); P.RS1 = (long long*)(ws + WS_RS1); P.RS2 = (long long*)(ws + WS_RS2);
    return P;
}

__device__ __forceinline__ float wave_sum(float v) {
#pragma unroll
    for (int o = 1; o < 64; o <<= 1) v += __shfl_xor(v, o);
    return v;
}
__device__ __forceinline__ void p0_transpose_item(const float* W, int N, bf16* WT, int ldk, int koff, int drow0, int k0, int n0, LAS float* scr, int lane) {
#pragma unroll 8
    for (int i = 0; i < 32; ++i) { const int kk = 2 * i + (lane >> 5); scr[kk * 33 + (lane & 31)] = W[(size_t)(k0 + kk) * N + n0 + (lane & 31)]; }
    asm volatile("s_waitcnt lgkmcnt(0)" ::: "memory");
    const int c = lane & 7;
#pragma unroll
    for (int j = 0; j < 4; ++j) { const int n = (lane >> 3) + 8 * j; const LAS float* s = scr + (8 * c) * 33 + n;
        v4u o; o.x = pk2(s[0 * 33], s[1 * 33]); o.y = pk2(s[2 * 33], s[3 * 33]); o.z = pk2(s[4 * 33], s[5 * 33]); o.w = pk2(s[6 * 33], s[7 * 33]);
        *(GAS v4u*)(WT + (size_t)(drow0 + n) * ldk + koff + k0 + 8 * c) = o; }
    asm volatile("s_waitcnt lgkmcnt(0)" ::: "memory");
}
template <bool TO_BF16, bool TO_F32>
__device__ __forceinline__ void ln_row(const float* xrow, const float* g, const float* b, bf16* orow, float* frow, f32x2* stat, int lane) {
    const GAS f32x4* xr = (const GAS f32x4*)xrow + lane;
    f32x4 v[4]; float s = 0.f;
#pragma unroll
    for (int j = 0; j < 4; ++j) { v[j] = xr[64 * j]; s += (v[j].x + v[j].y) + (v[j].z + v[j].w); }
    const float mean = wave_sum(s) * (1.f / DM); float s2 = 0.f;
#pragma unroll
    for (int j = 0; j < 4; ++j) { v[j] = v[j] - mean; s2 += (v[j].x * v[j].x + v[j].y * v[j].y) + (v[j].z * v[j].z + v[j].w * v[j].w); }
    const float rstd = 1.f / sqrtf(wave_sum(s2) * (1.f / DM) + LN_EPS);
    if (stat && lane == 0) *stat = (f32x2){mean, rstd};
#pragma unroll
    for (int j = 0; j < 4; ++j) { const f32x4 gg = ((const GAS f32x4*)g)[lane + 64 * j], bb = ((const GAS f32x4*)b)[lane + 64 * j]; const f32x4 y = v[j] * rstd * gg + bb;
        if (TO_BF16) ((GAS unsigned long long*)orow)[lane + 64 * j] = (unsigned long long)pk2(y.x, y.y) | ((unsigned long long)pk2(y.z, y.w) << 32);
        if (TO_F32) ((GAS f32x4*)frow)[lane + 64 * j] = y; }
}

__device__ __forceinline__ void ln_apply_row(const float* zrow, const long long* RS, int m, const float* g, const float* b, float* orow, int lane) {
    float mean, rstd; pg8::fx_stats(RS, (unsigned)m, LN_EPS, mean, rstd);
#pragma unroll
    for (int j = 0; j < 4; ++j) { const f32x4 v = ((const GAS f32x4*)zrow)[lane + 64 * j], gg = ((const GAS f32x4*)g)[lane + 64 * j], bb = ((const GAS f32x4*)b)[lane + 64 * j];
        ((GAS f32x4*)orow)[lane + 64 * j] = (v - mean) * rstd * gg + bb; }
}

__device__ __forceinline__ void p0_prologue(Frame& F) {
    const Ptrs P = get_ptrs();
    LAS float* scr = (LAS float*)(F.lds + F.wave * 16384);
    const int gw = F.vcu * NWAVES + F.wave, NGW = F.G * NWAVES;
    constexpr int I_IN = (DM / 64) * (NIN / 32), I_OA = (512 / 64) * (DM / 32), I_OUT = (DM / 64) * (DM / 32), I_G = (DM / 64) * (DFF / 32), I_D = (DFF / 64) * (DM / 32);
    constexpr int NITEMS = I_IN + 2 * I_OA + I_OUT + 2 * I_G + I_D;
    for (int it = gw; it < NITEMS; it += NGW) {
        int r = it;
        if (r < I_IN) { const int nb = NIN / 32, kb = r / nb, n0 = 32 * (r % nb); p0_transpose_item(P.w_in, NIN, P.WinT, DM, 0, n0, 64 * kb, n0, scr, F.lane); continue; } r -= I_IN;
        if (r < I_OA) { const int nb = DM / 32, kb = r / nb, n0 = 32 * (r % nb); p0_transpose_item(P.w_oa, DM, P.WoabT, DM, 0, n0, 64 * kb, n0, scr, F.lane); continue; } r -= I_OA;
        if (r < I_OA) { const int nb = DM / 32, kb = r / nb, n0 = 32 * (r % nb); p0_transpose_item(P.w_ob, DM, P.WoabT, DM, 512, n0, 64 * kb, n0, scr, F.lane); continue; } r -= I_OA;
        if (r < I_OUT) { const int nb = DM / 32, kb = r / nb, n0 = 32 * (r % nb); p0_transpose_item(P.w_out, DM, P.WoutT, DM, 0, n0, 64 * kb, n0, scr, F.lane); continue; } r -= I_OUT;
        if (r < I_G) { const int nb = DFF / 32, kb = r / nb, n0 = 32 * (r % nb); p0_transpose_item(P.w_gate, DFF, P.WgvT, DM, 0, 256 * (n0 / 128) + (n0 % 128), 64 * kb, n0, scr, F.lane); continue; } r -= I_G;
        if (r < I_G) { const int nb = DFF / 32, kb = r / nb, n0 = 32 * (r % nb); p0_transpose_item(P.w_val, DFF, P.WgvT, DM, 0, 256 * (n0 / 128) + 128 + (n0 % 128), 64 * kb, n0, scr, F.lane); continue; } r -= I_G;
        { const int nb = DM / 32, kb = r / nb, n0 = 32 * (r % nb); p0_transpose_item(P.w_down, DM, P.WdT, DFF, 0, n0, 64 * kb, n0, scr, F.lane); }
    }
    { const int gt = (F.vcu * NWAVES + F.wave) * 64 + F.lane;
      if (gt < 64 * 32) { const int pos = gt >> 5, k = gt & 31; const float freq = powf(10000.0f, -(float)k / 32.0f), ang = (float)pos * freq;
          P.ROPE[2 * gt] = cosf(ang); P.ROPE[2 * gt + 1] = sinf(ang); } }
    for (int m = gw; m < M; m += NGW) { ln_row<true, false>(P.x + (size_t)m * DM, P.ln_in_g, P.ln_in_b, P.H0B + (size_t)m * DM, nullptr, P.STAT0 + m, F.lane);
        if (F.lane < 2) { P.RS1[2 * (size_t)m + F.lane] = 0; P.RS2[2 * (size_t)m + F.lane] = 0; } }
}

__device__ __forceinline__ void p1b_norm_rope(Frame& F) {
    const Ptrs P = get_ptrs();
    const int gw = F.vcu * NWAVES + F.wave, NGW = F.G * NWAVES;
    const int j = F.lane & 15, sub = F.lane >> 4;
    for (int it = gw; it < M + M / 2; it += NGW) {
        const bool isq = it < M; const int hv = (isq ? it : it - M) * 4 + sub;
        bf16* p = (isq ? P.QB : P.KB) + (size_t)hv * 128 + 8 * j;
        const int t = isq ? (hv >> 2) : (hv >> 1), ts = t & (SEQ - 1), pos = (j & 8) ? (ts & 63) : (ts >> 6);
        const float* sc = (isq ? P.bq_norm : P.bk_norm) + 8 * j;
        const v4u w = *(const GAS v4u*)p;
        float v[8] = {__uint_as_float(w.x << 16), __uint_as_float(w.x & 0xffff0000u), __uint_as_float(w.y << 16), __uint_as_float(w.y & 0xffff0000u),
                      __uint_as_float(w.z << 16), __uint_as_float(w.z & 0xffff0000u), __uint_as_float(w.w << 16), __uint_as_float(w.w & 0xffff0000u)};
        float ss = 0.f;
#pragma unroll
        for (int e = 0; e < 8; ++e) ss += v[e] * v[e];
        ss += __shfl_xor(ss, 1); ss += __shfl_xor(ss, 2); ss += __shfl_xor(ss, 4); ss += __shfl_xor(ss, 8);
        const float rstd = 1.0f / sqrtf(ss * (1.0f / 128.0f) + RMS_EPS);
        const f32x4 s0 = *(const GAS f32x4*)sc, s1 = *(const GAS f32x4*)(sc + 4);
        const float scv[8] = {s0.x, s0.y, s0.z, s0.w, s1.x, s1.y, s1.z, s1.w};
        const float* tab = P.ROPE + ((size_t)pos * 32 + 8 * (j & 3)) * 2;
        float o[8];
#pragma unroll
        for (int e = 0; e < 8; ++e) { const float y = v[e] * rstd * scv[e]; const float py = __shfl_xor(y, 4);
            const float cs = tab[2 * e], sn = tab[2 * e + 1];
            o[e] = (j & 4) ? (py * sn + y * cs) : (y * cs - py * sn); }
        v4u ow; ow.x = pk2(o[0], o[1]); ow.y = pk2(o[2], o[3]); ow.z = pk2(o[4], o[5]); ow.w = pk2(o[6], o[7]);
        *(GAS v4u*)p = ow;
    }
}

__device__ __forceinline__ void p1c_fold_vectors(Frame& F) {
    const Ptrs P = get_ptrs();
    const int gw = F.vcu * NWAVES + F.wave, NGW = F.G * NWAVES;
    for (int n = gw; n < NGV; n += NGW) {
        float s1 = 0.f, s2 = 0.f;
#pragma unroll
        for (int i = 0; i < 2; ++i) { const int k = (F.lane + 64 * i) * 8; const v4u w = *(const GAS v4u*)(P.WgvT + (size_t)n * DM + k);
            const f32x4 ga = *(const GAS f32x4*)(P.ln1_g + k), gb = *(const GAS f32x4*)(P.ln1_g + k + 4), ba = *(const GAS f32x4*)(P.ln1_b + k), bb = *(const GAS f32x4*)(P.ln1_b + k + 4);
            const float wv[8] = {__uint_as_float(w.x << 16), __uint_as_float(w.x & 0xffff0000u), __uint_as_float(w.y << 16), __uint_as_float(w.y & 0xffff0000u),
                                 __uint_as_float(w.z << 16), __uint_as_float(w.z & 0xffff0000u), __uint_as_float(w.w << 16), __uint_as_float(w.w & 0xffff0000u)};
            s1 += wv[0] * ga.x + wv[1] * ga.y + wv[2] * ga.z + wv[3] * ga.w + wv[4] * gb.x + wv[5] * gb.y + wv[6] * gb.z + wv[7] * gb.w;
            s2 += wv[0] * ba.x + wv[1] * ba.y + wv[2] * ba.z + wv[3] * ba.w + wv[4] * bb.x + wv[5] * bb.y + wv[6] * bb.z + wv[7] * bb.w; }
        s1 = wave_sum(s1); s2 = wave_sum(s2);
        if (F.lane == 0) { P.C1[n] = s1; P.C2[n] = s2; }
    }
}

__device__ __forceinline__ void p5b_fixup(Frame& F) {
    const Ptrs P = get_ptrs();
    const int gt = (F.vcu * NWAVES + F.wave) * 64 + F.lane, NGT = F.G * NWAVES * 64;
    constexpr int NT = M / 256;
    for (int i = gt; i < NT * 2 * DFF; i += NGT) {
        const int c = i % DFF, ts = i / DFF, side = ts & 1, pm = ts >> 1;
        float ext = 0.f; int row;
        if (side == 0) { row = 256 * pm; if ((pm & 15) != 0) ext = P.Gb[((size_t)(pm - 1) * 2 + 1) * DFF + c]; ext *= P.conv_w[c]; }
        else { row = 256 * pm + 255; if ((pm & 15) != 15) ext = P.Gb[((size_t)(pm + 1) * 2 + 0) * DFF + c]; ext *= P.conv_w[2 * DFF + c]; }
        const float cv = P.Pb[(size_t)i] + ext;
        const pg8::f32x2 ge = pg8::gelu_pk((pg8::f32x2){cv, 0.f});
        P.ACT[(size_t)row * DFF + c] = (bf16)f2bf(ge.x * P.Vbnd[(size_t)i]);
    }
}
#ifndef PHM
#define PHM 0x3ff
#endif
#ifndef REPM
#define REPM 0
#endif
#define REP(k) for (int rep_ = 0; rep_ < (((REPM) >> (k)) & 1) + 1; ++rep_)

#if DBG
namespace dbg {
constexpr int NS = 4096;
__device__ __forceinline__ unsigned h32(unsigned x) { x ^= x >> 16; x *= 0x7feb352du; x ^= x >> 15; x *= 0x846ca68bu; x ^= x >> 16; return x; }
__device__ __forceinline__ void flag(unsigned* ctl, int k) { __hip_atomic_store(ctl + CW_ERR + k, 1u, __ATOMIC_RELAXED, __HIP_MEMORY_SCOPE_AGENT); }
__device__ __forceinline__ bool far(float a, float ref, float rtol, float atol) { return !(fabsf(a - ref) <= atol + rtol * fabsf(ref)); }
__device__ __forceinline__ float wmax(float v) {
#pragma unroll
    for (int o = 1; o < 64; o <<= 1) v = fmaxf(v, __shfl_xor(v, o));
    return v; }
__device__ __forceinline__ float wdot(const bf16* a, const bf16* b, int K, int lane) { float s = 0.f; for (int k = lane; k < K; k += 64) s += bf2f(a[k]) * bf2f(b[k]); return wave_sum(s); }
#define DBG_LOOP(s) const int gw = F.vcu * NWAVES + F.wave, NGW = F.G * NWAVES; for (int s = gw; s < NS; s += NGW)

__device__ __forceinline__ void chk_w(Frame& F, const float* W, int K, int N, const bf16* WT, int ldk, int koff, int mode, unsigned seed, bool& bad) {
    const unsigned r = h32(seed * 64u + F.lane); const int n = (r >> 8) % N, k = (r >> 20 ^ r) % K;
    const int dr = mode == 0 ? n : (256 * (n / 128) + (n % 128) + (mode == 2 ? 128 : 0));
    const unsigned ref = f2bf(W[(size_t)k * N + n]);
    if ((unsigned)WT[(size_t)dr * ldk + koff + k] != ref) bad = true;
}
__device__ __forceinline__ void check_0(Frame& F, char* lds) {
    const Ptrs P = get_ptrs();
    bool bad = false;
    DBG_LOOP(s) {
        const unsigned sd = (unsigned)s * 7u;
        chk_w(F, P.w_in, DM, NIN, P.WinT, DM, 0, 0, sd + 0, bad);
        chk_w(F, P.w_oa, 512, DM, P.WoabT, DM, 0, 0, sd + 1, bad);
        chk_w(F, P.w_ob, 512, DM, P.WoabT, DM, 512, 0, sd + 2, bad);
        chk_w(F, P.w_out, DM, DM, P.WoutT, DM, 0, 0, sd + 3, bad);
        chk_w(F, P.w_gate, DM, DFF, P.WgvT, DM, 0, 1, sd + 4, bad);
        chk_w(F, P.w_val, DM, DFF, P.WgvT, DM, 0, 2, sd + 5, bad);
        chk_w(F, P.w_down, DFF, DM, P.WdT, DFF, 0, 0, sd + 6, bad);
        const int row = h32(s + 777u) % M; const float* xr = P.x + (size_t)row * DM;
        float sm = 0.f; for (int k = F.lane; k < DM; k += 64) sm += xr[k];
        const float mean = wave_sum(sm) / DM; float s2 = 0.f; for (int k = F.lane; k < DM; k += 64) { const float d = xr[k] - mean; s2 += d * d; }
        const float rstd = 1.0f / sqrtf(wave_sum(s2) / DM + LN_EPS);
        for (int k = F.lane; k < DM; k += 64) { const float ref = (xr[k] - mean) * rstd * P.ln_in_g[k] + P.ln_in_b[k]; if (far(bf2f(P.H0B[(size_t)row * DM + k]), ref, 1e-2f, 1e-2f)) bad = true; }
        const f32x2 st = P.STAT0[row]; if (far(st.x, mean, 1e-3f, 1e-4f) || far(st.y, rstd, 1e-3f, 1e-4f)) bad = true;
    }
    if (bad) flag(P.ctl, 0);
}
__device__ __forceinline__ void check_1(Frame& F, char* lds) {
    const Ptrs P = get_ptrs();
    bool bad = false;
    DBG_LOOP(s) {
        const unsigned r = h32(s + 1000u); const int row = r % M, col = (r >> 15) % NIN;
        const float ref = wdot(P.H0B + (size_t)row * DM, P.WinT + (size_t)col * DM, DM, F.lane) + P.b_in[col];
        float got, want = ref;
        if (col < 512) got = bf2f(P.QA[(size_t)row * 512 + col]);
        else if (col < 640) got = bf2f(P.KVA[(size_t)row * 256 + col - 512]);
        else if (col < 768) got = bf2f(P.KVA[(size_t)row * 256 + 128 + col - 640]);
        else if (col < 1280) got = bf2f(P.QB[(size_t)row * 512 + col - 768]);
        else if (col < 1536) got = bf2f(P.KB[(size_t)row * 256 + col - 1280]);
        else if (col < 1792) got = bf2f(P.VB[(size_t)row * 256 + col - 1536]);
        else { got = bf2f(P.GATES[(size_t)row * 2048 + col - 1792]); want = 1.0f / (1.0f + expf(-ref)); }
        if (far(got, want, 2e-2f, 2e-2f)) bad = true;
    }
    if (bad) flag(P.ctl, 1);
}
__device__ __forceinline__ void check_2(Frame& F, char* lds) {
    const Ptrs P = get_ptrs();
    bool bad = false;
    DBG_LOOP(s) {
        const unsigned r = h32(s + 2000u); const int row = r % M, hd = (r >> 15) % 6;
        const int colbase = hd < 4 ? 768 + hd * 128 : 1280 + (hd - 4) * 128;
        const bf16* stored = hd < 4 ? P.QB + (size_t)row * 512 + hd * 128 : P.KB + (size_t)row * 256 + (hd - 4) * 128;
        const float* sc = hd < 4 ? P.bq_norm : P.bk_norm;
        float raw[2], y[2];
#pragma unroll
        for (int q = 0; q < 2; ++q) { const int d = F.lane + 64 * q; float acc = 0.f; const bf16* a = P.H0B + (size_t)row * DM; const bf16* b = P.WinT + (size_t)(colbase + d) * DM;
            for (int k = 0; k < DM; ++k) acc += bf2f(a[k]) * bf2f(b[k]); raw[q] = bf2f((bf16)f2bf(acc + P.b_in[colbase + d])); }
        const float rstd = 1.0f / sqrtf(wave_sum(raw[0] * raw[0] + raw[1] * raw[1]) / 128.0f + RMS_EPS);
        const int ts = row & (SEQ - 1);
#pragma unroll
        for (int q = 0; q < 2; ++q) y[q] = raw[q] * rstd * sc[F.lane + 64 * q];
#pragma unroll
        for (int q = 0; q < 2; ++q) { const float py = __shfl_xor(y[q], 32); const int dd = F.lane, k = dd & 31; const int pos = q == 0 ? (ts >> 6) : (ts & 63);
            const float ang = (float)pos * powf(10000.0f, -(float)k / 32.0f), cs = cosf(ang), sn = sinf(ang);
            const float ref = dd < 32 ? (y[q] * cs - py * sn) : (py * sn + y[q] * cs);
            if (far(bf2f(stored[F.lane + 64 * q]), ref, 2e-2f, 4e-2f)) bad = true; }
    }
    if (bad) flag(P.ctl, 2);
}
__device__ __forceinline__ void check_3(Frame& F, char* lds) {
    const Ptrs P = get_ptrs();
    bool bad = false; float* pl = (float*)lds + F.wave * 4096;
    DBG_LOOP(s) {
        const unsigned r = h32(s + 3000u); int row = r % M; const int hsel = (r >> 15) % 12; const int ts = row & (SEQ - 1), b = row / SEQ;
        if (s < 512) { const int e = s & 7; const int tsn = e == 0 ? 0 : e == 1 ? 1 : e == 2 ? SEQ - 1 : e == 3 ? SEQ - 2 : e == 4 ? 127 : e == 5 ? 128 : e == 6 ? 129 : SEQ - 129; row = b * SEQ + tsn; }
        const int tq = row & (SEQ - 1);
        if (hsel < 8) {
            const int h = hsel, kvh = h >> 2; const float slope = exp2f(-(float)(h + 1)), sink = P.a_sinks[h];
            float sc[5]; float mx = sink;
#pragma unroll
            for (int j = 0; j < 5; ++j) { const int i = F.lane + 64 * j, kp = tq - 128 + i; sc[j] = -INFINITY;
                if (i < 257 && kp >= 0 && kp < SEQ) { float d = 0.f; const bf16* q = P.QA + (size_t)row * 512 + h * 64; const bf16* kk = P.KVA + ((size_t)b * SEQ + kp) * 256 + kvh * 64;
                    for (int e = 0; e < 64; ++e) d += bf2f(q[e]) * bf2f(kk[e]); sc[j] = d * 0.125f - slope * fabsf((float)(tq - kp)); }
                mx = fmaxf(mx, sc[j]); }
            mx = wmax(mx); float sm = 0.f;
#pragma unroll
            for (int j = 0; j < 5; ++j) { const float p = expf(sc[j] - mx); pl[F.lane + 64 * j] = p; sm += p; }
            const float den = wave_sum(sm) + expf(sink - mx);
            __builtin_amdgcn_s_waitcnt(0);
            float o = 0.f; for (int i = 0; i < 257; ++i) { const int kp = tq - 128 + i; if (kp >= 0 && kp < SEQ) o += pl[i] * bf2f(P.KVA[((size_t)b * SEQ + kp) * 256 + 128 + kvh * 64 + F.lane]); }
            o /= den;
            if (far(bf2f(P.OAB[(size_t)row * 1024 + h * 64 + F.lane]), o, 3e-2f, 5e-3f)) bad = true;
        } else {
            const int h = hsel - 8 < 4 ? hsel - 8 : 0, kvh = h >> 1; float mx = -INFINITY;
            const bf16* q = P.QB + (size_t)row * 512 + h * 128;
            for (int j = 0; j < 64; ++j) { const int kp = F.lane + 64 * j; const bf16* kk = P.KB + ((size_t)b * SEQ + kp) * 256 + kvh * 128; float d = 0.f;
                for (int e = 0; e < 128; ++e) d += bf2f(q[e]) * bf2f(kk[e]); d *= 0.08838834764831845f; pl[kp] = d; mx = fmaxf(mx, d); }
            mx = wmax(mx); float sm = 0.f;
            for (int j = 0; j < 64; ++j) { const int kp = F.lane + 64 * j; const float p = expf(pl[kp] - mx); pl[kp] = p; sm += p; }
            const float den = wave_sum(sm);
            __builtin_amdgcn_s_waitcnt(0);
            for (int qd = 0; qd < 2; ++qd) { float o = 0.f; for (int kp = 0; kp < SEQ; ++kp) o += pl[kp] * bf2f(P.VB[((size_t)b * SEQ + kp) * 256 + kvh * 128 + F.lane + 64 * qd]); o /= den;
                if (far(bf2f(P.OAB[(size_t)row * 1024 + 512 + h * 128 + F.lane + 64 * qd]), o, 3e-2f, 5e-3f)) bad = true; }
        }
        __builtin_amdgcn_s_waitcnt(0);
    }
    if (bad) flag(P.ctl, 3);
}
__device__ __forceinline__ void check_4(Frame& F, char* lds) {
    const Ptrs P = get_ptrs();
    bool bad = false;
    DBG_LOOP(s) {
        const unsigned r = h32(s + 4000u); const int row = r % M, col = (r >> 15) % DM;
        const float pa = wdot(P.OAB + (size_t)row * 1024, P.WoabT + (size_t)col * DM, 512, F.lane), pb = wdot(P.OAB + (size_t)row * 1024 + 512, P.WoabT + (size_t)col * DM + 512, 512, F.lane);
        const float ref = bf2f(P.GATES[(size_t)row * 2048 + col]) * pa + bf2f(P.GATES[(size_t)row * 2048 + 1024 + col]) * pb;
        if (far(bf2f(P.MERGED[(size_t)row * DM + col]), ref, 3e-2f, 1e-3f)) bad = true;
    }
    if (bad) flag(P.ctl, 4);
}
__device__ __forceinline__ void row_stats(const float* xr, int lane, float& mean, float& rstd, float& sm_, float& sq_) {
    float sm = 0.f, sq = 0.f; for (int k = lane; k < DM; k += 64) { sm += xr[k]; sq += xr[k] * xr[k]; }
    sm = wave_sum(sm); sq = wave_sum(sq); mean = sm / DM; float s2 = 0.f; for (int k = lane; k < DM; k += 64) { const float d = xr[k] - mean; s2 += d * d; }
    rstd = 1.0f / sqrtf(wave_sum(s2) / DM + LN_EPS); sm_ = sm; sq_ = sq;
}
__device__ __forceinline__ void check_5(Frame& F, char* lds) {
    const Ptrs P = get_ptrs();
    bool bad = false;
    DBG_LOOP(s) {
        const unsigned r = h32(s + 5000u); const int row = r % M, col = (r >> 15) % DM;
        const float y = wdot(P.MERGED + (size_t)row * DM, P.WoutT + (size_t)col * DM, DM, F.lane);
        float mean, rstd, a_, b_; row_stats(P.x + (size_t)row * DM, F.lane, mean, rstd, a_, b_);
        const float ref = ALPHA * ((P.x[(size_t)row * DM + col] - mean) * rstd * P.ln_in_g[col] + P.ln_in_b[col]) + y;
        if (far(P.out[(size_t)row * DM + col], ref, 1e-3f, 1e-3f)) bad = true;
        if (far(bf2f(P.H0B[(size_t)row * DM + col]), ref * P.ln1_g[col], 1e-2f, 1e-2f)) bad = true;
        float m1, r1, sm, sq; row_stats(P.out + (size_t)row * DM, F.lane, m1, r1, sm, sq);
        const float gs = (float)P.RS1[2 * (size_t)row] * (1.0f / 1099511627776.0f), gq = (float)P.RS1[2 * (size_t)row + 1] * (1.0f / 1099511627776.0f);
        if (far(gs, sm, 1e-3f, 1e-2f) || far(gq, sq, 1e-3f, 1e-2f)) bad = true;
    }
    if (bad) flag(P.ctl, 5);
}
__device__ __forceinline__ void check_6(Frame& F, char* lds) {}
__device__ __forceinline__ float h1dot(const Ptrs& P, int row, const bf16* w, int lane) {
    const float* zr = P.out + (size_t)row * DM; float mean, rstd, a_, b_; row_stats(zr, lane, mean, rstd, a_, b_);
    float s = 0.f; for (int k = lane; k < DM; k += 64) s += ((zr[k] - mean) * rstd * P.ln1_g[k] + P.ln1_b[k]) * bf2f(w[k]); return wave_sum(s);
}
__device__ __forceinline__ void check_7(Frame& F, char* lds) {
    const Ptrs P = get_ptrs();
    bool bad = false;
    DBG_LOOP(s) {
        const unsigned r = h32(s + 7000u); int row = r % M; const int ch = (r >> 15) % DFF;
        if (s < 3072) { const int e = s % 12; const int off = e == 0 ? 0 : e == 1 ? 255 : e == 2 ? 63 : e == 3 ? 64 : e == 4 ? 127 : e == 5 ? 128 : e == 6 ? 191 : e == 7 ? 192 : e == 8 ? 15 : e == 9 ? 16 : e == 10 ? 1 : 254; row = (row & ~255) + off; }
        const int ts = row & (SEQ - 1);
        const bf16* wg = P.WgvT + (size_t)(256 * (ch / 128) + (ch % 128)) * DM; const bf16* wv = wg + (size_t)128 * DM;
        const float g0 = ts > 0 ? h1dot(P, row - 1, wg, F.lane) : 0.f, g1 = h1dot(P, row, wg, F.lane);
        const float g2 = ts < SEQ - 1 ? h1dot(P, row + 1, wg, F.lane) : 0.f, v = h1dot(P, row, wv, F.lane);
        const float cv = P.conv_w[ch] * g0 + P.conv_w[DFF + ch] * g1 + P.conv_w[2 * DFF + ch] * g2 + P.conv_b[ch];
        const float ref = 0.5f * cv * (1.0f + erff(cv * 0.7071067811865476f)) * v;
        if (far(bf2f(P.ACT[(size_t)row * DFF + ch]), ref, 3e-2f, 8e-3f)) bad = true;
    }
    if (bad) flag(P.ctl, 7);
}
__device__ __forceinline__ void check_8(Frame& F, char* lds) {
    const Ptrs P = get_ptrs();
    bool bad = false;
    DBG_LOOP(s) {
        const unsigned r = h32(s + 8000u); const int row = r % M, col = (r >> 15) % DM;
        const float y = wdot(P.ACT + (size_t)row * DFF, P.WdT + (size_t)col * DFF, DFF, F.lane);
        float mu, rs; pg8::fx_stats(P.RS1, (unsigned)row, LN_EPS, mu, rs);
        const float ref = ALPHA * ((bf2f(P.H0B[(size_t)row * DM + col]) - mu * P.ln1_g[col]) * rs + P.ln1_b[col]) + y;
        if (far(P.out[(size_t)row * DM + col], ref, 1e-2f, 3e-2f)) bad = true;
    }
    if (bad) flag(P.ctl, 8);
}
}
#endif

__global__ void __launch_bounds__(NWAVES * 64, 2) fwd_megakernel(Args args) {
    extern __shared__ __attribute__((aligned(16))) unsigned char lds[];
    Frame F;
    F.lds = (LAS unsigned char*)lds;
    F.tid = threadIdx.x; F.lane = F.tid & 63; F.wave = __builtin_amdgcn_readfirstlane(F.tid >> 6);
    F.G = gridDim.x; { const int bx = blockIdx.x; F.vcu = (F.G % 8 == 0) ? (bx % 8) * (F.G / 8) + bx / 8 : bx; }
    LAS unsigned char* ring = F.lds; LAS unsigned char* xlds = F.lds + XLDS_OFF;
    const int gw = F.vcu * NWAVES + F.wave, NGW = F.G * NWAVES;
    { volatile LAS unsigned* misc = (volatile LAS unsigned*)(F.lds + MISC_OFF); if (F.tid < 16) misc[F.tid] = 0u; }
    __syncthreads();
    XcdBarrier xbar;
    { const Ptrs P = get_ptrs(); xbar = xcd_barrier_post(P.ctl + CW_BAR, (volatile LAS unsigned*)(F.lds + MISC_OFF)); }
#ifdef STAMP
    volatile LAS unsigned long long* stamps = (volatile LAS unsigned long long*)(F.lds + MISC_OFF + 128); int nst = 0;
    const bool stamper = (blockIdx.x == 0 && F.tid == 0);
#define TSTAMP() do { if (stamper) stamps[nst] = __builtin_amdgcn_s_memrealtime(); ++nst; } while (0)
#else
#define TSTAMP() do {} while (0)
#endif
    TSTAMP();
#define GRID_BAR() do { xcd_barrier(xbar); TSTAMP(); } while (0)
#if DBG
#define CHECK(k) do { dbg::check_##k(F, (char*)lds); GRID_BAR(); } while (0)
#else
#define CHECK(k) do {} while (0)
#endif

#if PHM & (1<<0)
    REP(0) { p0_prologue(F);
    GRID_BAR(); }
    CHECK(0);

#endif
#if PHM & (1<<1)
    REP(1) {
    {
        const Ptrs P = get_ptrs();
        pg8::Gemm g{P.H0B, P.WinT, DM, DM, DM}; pg8::StaticOrder S; S.init(M, NIN, F.G, (int)blockIdx.x);
        pg8::EpiU E{P.QA, P.KVA, P.QB, P.KB, P.VB, P.GATES, P.b_in};
        pg8::gemm_phase<pg8::EpiU, pg8::StaticOrder, true>(ring, xlds, g, S, E);
    }
    GRID_BAR();
    CHECK(1);

#endif
#if PHM & (1<<2)
    p1b_norm_rope(F);
    p1c_fold_vectors(F);
    GRID_BAR();
    }
    CHECK(2);

#endif
#if PHM & (1<<3)
    {
        const Ptrs P = get_ptrs();
#ifndef NO_DENSE
        REP(3)
        for (int u = F.vcu; u < BATCH * 4 * (SEQ / 256); u += F.G) {
            const int qb = u & 15, h = (u >> 4) & 3, b = u >> 6, kvh = h >> 1;
            const size_t r0 = (size_t)b * SEQ + (size_t)qb * 256;
            attn::dense::body(P.QB + r0 * 512 + h * 128, P.KB + (size_t)b * SEQ * 256 + kvh * 128, P.VB + (size_t)b * SEQ * 256 + kvh * 128, P.OAB + r0 * 1024 + 512 + h * 128, SEQ, (char*)lds);
        }
#endif
        __syncthreads(); TSTAMP();
#ifndef NO_WIN
        REP(10)
        attn::win::run(P.QA, P.KVA, P.OAB, P.a_sinks, F.vcu, F.G, BATCH * 2 * (SEQ / 64), (char*)lds);
        TSTAMP();
#endif
    }
    GRID_BAR();
    CHECK(3);

#endif
#if PHM & (1<<4)
    REP(4) {
    {
        const Ptrs P = get_ptrs();
        pg8::Gemm g{P.OAB, P.WoabT, DM, DM, 512}; pg8::StaticOrder S; S.init(M, DM, F.G, (int)blockIdx.x, 2);
        pg8::EpiGate E{P.GATES, P.MERGED};
        pg8::gemm_phase<pg8::EpiGate, pg8::StaticOrder, true>(ring, xlds, g, S, E);
    }
    GRID_BAR(); }
    CHECK(4);

#endif
#if PHM & (1<<5)
    REP(5) {
#if (REPM >> 5) & 1
    { const Ptrs P = get_ptrs(); for (int m = gw * 64 + F.lane; m < 2 * M; m += NGW * 64) P.RS1[m] = 0; }
    GRID_BAR();
#endif
    {
        const Ptrs P = get_ptrs();
        pg8::Gemm g{P.MERGED, P.WoutT, DM, DM, DM}; pg8::StaticOrder S; S.init(M, DM, F.G, (int)blockIdx.x);
        pg8::EpiRes<true> E{P.x, P.STAT0, nullptr, P.ln_in_g, P.ln_in_b, P.out, P.RS1, P.ln1_g, P.H0B};
        pg8::gemm_phase<pg8::EpiRes<true>, pg8::StaticOrder, true>(ring, xlds, g, S, E);
    }
    GRID_BAR(); }
    CHECK(5);

#endif
#if PHM & (1<<6)
    CHECK(6);

#endif
#if PHM & (1<<7)
    REP(7) {
    {
        const Ptrs P = get_ptrs();
        pg8::Gemm g{P.H0B, P.WgvT, DM, DM, DM}; pg8::StaticOrder S; S.init(M, NGV, F.G, (int)blockIdx.x);
        pg8::EpiFfnUp E{P.ACT, P.conv_w, P.conv_b, P.Pb, P.Gb, P.Vbnd, P.RS1, P.C1, P.C2};
        pg8::gemm_phase<pg8::EpiFfnUp, pg8::StaticOrder, true>(ring, xlds, g, S, E);
    }
    GRID_BAR();
    p5b_fixup(F);
    GRID_BAR(); }
    CHECK(7);

#endif
#if PHM & (1<<8)
#if (REPM >> 8) & 1
    {
        const Ptrs P = get_ptrs();
        pg8::Gemm g{P.ACT, P.WdT, DFF, DFF, DFF}; pg8::StaticOrder S; S.init(M, DM, F.G, (int)blockIdx.x);
        pg8::EpiRes<false> E{P.out, nullptr, P.RS1, P.ln1_g, P.ln1_b, (float*)P.OAB, (long long*)P.H0B, nullptr, nullptr};
        pg8::gemm_phase<pg8::EpiRes<false>, pg8::StaticOrder, true>(ring, xlds, g, S, E);
    }
    GRID_BAR();
#endif
    {
        const Ptrs P = get_ptrs();
        pg8::Gemm g{P.ACT, P.WdT, DFF, DFF, DFF}; pg8::StaticOrder S; S.init(M, DM, F.G, (int)blockIdx.x);
        pg8::EpiRes<false> E{P.out, nullptr, P.RS1, P.ln1_g, P.ln1_b, P.out, P.RS2, nullptr, nullptr};
        pg8::gemm_phase<pg8::EpiRes<false>, pg8::StaticOrder, true>(ring, xlds, g, S, E);
    }
    GRID_BAR();
    CHECK(8);

#endif
#if PHM & (1<<9)
#if (REPM >> 9) & 1
    { const Ptrs P = get_ptrs(); for (int m = gw; m < M; m += NGW) ln_apply_row(P.out + (size_t)m * DM, P.RS2, m, P.ln2_g, P.ln2_b, (float*)P.OAB + (size_t)m * DM, F.lane); }
    GRID_BAR();
#endif
    {
        const Ptrs P = get_ptrs();
#if DBG
        float poison = 0.f;
        for (int k = 0; k < 16; ++k) if (poison == 0.f && __hip_atomic_load(P.ctl + CW_ERR + k, __ATOMIC_RELAXED, __HIP_MEMORY_SCOPE_AGENT) != 0u) poison = 64.f * (float)(k + 1);
#endif
        for (int m = gw; m < M; m += NGW) {
            ln_apply_row(P.out + (size_t)m * DM, P.RS2, m, P.ln2_g, P.ln2_b, P.out + (size_t)m * DM, F.lane);
#if DBG
            if (poison != 0.f && m == 0) { P.out[F.lane] += poison; }
#endif
        }
    }
#endif
#ifdef STAMP
    TSTAMP();
    if (stamper) { const Ptrs P = get_ptrs(); const float tot = (float)(stamps[nst - 1] - stamps[0]), ph = (float)(stamps[STAMP + 1] - stamps[STAMP]);
        P.out[0] += (STAMP == 99) ? tot * 0.01f * STAMP_SCALE : ph / tot * STAMP_SCALE; }
#endif
}

extern "C" void kernel_launch(void* const* d_in, const int* in_sizes, int n_in, void* d_out, int out_size, void* d_ws, size_t ws_size, hipStream_t stream) {
    static int grid = 0;
    if (grid == 0) {
        if (n_in != 20 || in_sizes[0] != M * DM || out_size != M * DM || ws_size < WS_END) {
            fprintf(stderr, "kernel_launch: shape mismatch: n_in %d in0 %d out %d ws %zu (need >= %zu)\n", n_in, n_in > 0 ? in_sizes[0] : -1, out_size, ws_size, (size_t)WS_END); grid = -1; return; }
        int dev = 0, cus = 0, per_cu = 0;
        if (hipGetDevice(&dev) != hipSuccess || hipDeviceGetAttribute(&cus, hipDeviceAttributeMultiprocessorCount, dev) != hipSuccess) { fprintf(stderr, "kernel_launch: device query failed\n"); grid = -1; return; }
        if (hipFuncSetAttribute((const void*)fwd_megakernel, hipFuncAttributeMaxDynamicSharedMemorySize, LDS_BYTES) != hipSuccess) { fprintf(stderr, "kernel_launch: hipFuncSetAttribute failed\n"); grid = -1; return; }
        if (hipOccupancyMaxActiveBlocksPerMultiprocessor(&per_cu, (const void*)fwd_megakernel, NWAVES * 64, LDS_BYTES) != hipSuccess || per_cu < 1) { fprintf(stderr, "kernel_launch: occupancy query failed (%d)\n", per_cu); (void)hipGetLastError(); grid = -1; return; }
        grid = cus * 1;
        fprintf(stderr, "kernel_launch: %d CUs, occupancy query %d blocks/CU, grid %d\n", cus, per_cu, grid);
    }
    if (grid < 0) return;
    if (hipMemsetAsync((char*)d_ws + WS_CTL, 0, CTL_ZERO_BYTES, stream) != hipSuccess) { fprintf(stderr, "kernel_launch: memset failed\n"); return; }
    Args a{};
    for (int i = 0; i < 20; ++i) a.in[i] = (const float*)d_in[i];
    a.out = (float*)d_out; a.ws = (unsigned char*)d_ws;
    void* kargs[] = {&a};
    const hipError_t e = hipLaunchCooperativeKernel((const void*)fwd_megakernel, dim3(grid), dim3(NWAVES * 64), kargs, LDS_BYTES, stream);
    if (e != hipSuccess) fprintf(stderr, "kernel_launch: cooperative launch failed: %s (grid %d)\n", hipGetErrorString(e), grid);
}
```

```cpp
#define DBG 0
#include <hip/hip_runtime.h>
#include <hip/hip_bf16.h>
#include <hip/hip_cooperative_groups.h>
#include <cstdio>
#include <cstdint>
#include <cmath>
namespace cg = cooperative_groups;
#define XB_LAS __attribute__((address_space(3)))
#define XB_TMO      128
#define XB_XCNT(j)  (256  + 64 * (j))
#define XB_XSUB(j)  (1280 + 64 * (j))
#define XB_XGEN(j)  (2304 + 64 * (j))
#define XB_TOP      3328
#define XB_TOPGEN   3392
#define XCD_BAR_WORDS 3456
#define XB_SPIN_CAP (1u << 18)
__device__ __forceinline__ unsigned xb_ld(unsigned* p)              { return __hip_atomic_load(p, __ATOMIC_RELAXED, __HIP_MEMORY_SCOPE_AGENT); }
__device__ __forceinline__ unsigned xb_add(unsigned* p, unsigned v) { return __hip_atomic_fetch_add(p, v, __ATOMIC_RELAXED, __HIP_MEMORY_SCOPE_AGENT); }
__device__ __forceinline__ unsigned xb_xcc_id() { return (unsigned)__builtin_amdgcn_s_getreg((3 << 11) | 20) & 0xFu; }
#define XB_SPIN(cond, bar) do { unsigned _sp = 0; while (cond) { __builtin_amdgcn_s_sleep(1); \
    if ((++_sp & 255u) == 0u) { if (xb_ld(&(bar)[XB_TMO])) break; if (_sp > XB_SPIN_CAP) { atomicAdd(&(bar)[XB_TMO], 1u); break; } } } } while (0)
struct XcdBarrier { unsigned* bar; unsigned x; volatile XB_LAS unsigned* st; };
__device__ __forceinline__ XcdBarrier xcd_barrier_post(unsigned* bar, volatile XB_LAS unsigned* st) {
    XcdBarrier b; b.bar = bar; b.x = xb_xcc_id(); b.st = st;
    if (threadIdx.x == 0) (void)xb_add(&bar[XB_XCNT(b.x)], 1u);
    return b;
}
__device__ __forceinline__ void xcd_barrier_complete(unsigned* bar, unsigned x, unsigned& nloc, unsigned& nx) {
    const unsigned G = gridDim.x * gridDim.y * gridDim.z;
    unsigned sum, cnt, mine, sp = 0u;
    for (;;) {
        sum = 0u; cnt = 0u; mine = 0u;
#pragma unroll
        for (unsigned j = 0; j < 16; ++j) { const unsigned c = xb_ld(&bar[XB_XCNT(j)]); sum += c; cnt += (c > 0u) ? 1u : 0u; mine = (j == x) ? c : mine; }
        if (sum == G) break;
        __builtin_amdgcn_s_sleep(1);
        if ((++sp & 255u) == 0u) { if (xb_ld(&bar[XB_TMO])) break; if (sp > XB_SPIN_CAP) { atomicAdd(&bar[XB_TMO], 1u); break; } }
    }
    nloc = mine > 0u ? mine : 1u; nx = cnt > 0u ? cnt : 1u;
}
__device__ __forceinline__ void xcd_barrier(const XcdBarrier& b) {
    asm volatile("s_waitcnt vmcnt(0)" ::: "memory");
    __syncthreads();
    if (threadIdx.x == 0) {
        unsigned* bar = b.bar;
        __builtin_amdgcn_s_waitcnt(0);
        unsigned nloc = b.st[0], nx = b.st[1];
        if (nloc == 0u) { xcd_barrier_complete(bar, b.x, nloc, nx); b.st[0] = nloc; b.st[1] = nx; }
        const unsigned old = xb_add(&bar[XB_XSUB(b.x)], 1u);
        const unsigned gen = old / nloc;
        if (old + 1u == (gen + 1u) * nloc) {
            __builtin_amdgcn_fence(__ATOMIC_RELEASE, "agent");
            asm volatile("s_waitcnt vmcnt(0)" ::: "memory");
            const unsigned og = xb_add(&bar[XB_TOP], 1u);
            const unsigned tg = og / nx;
            if (og + 1u == (tg + 1u) * nx) xb_add(&bar[XB_TOPGEN], 1u);
            else XB_SPIN(xb_ld(&bar[XB_TOPGEN]) == tg, bar);
            __builtin_amdgcn_fence(__ATOMIC_ACQUIRE, "agent");
            xb_add(&bar[XB_XGEN(b.x)], 1u);
            asm volatile("s_waitcnt vmcnt(0)" ::: "memory");
        } else {
            XB_SPIN(xb_ld(&bar[XB_XGEN(b.x)]) == gen, bar);
            __builtin_amdgcn_fence(__ATOMIC_ACQUIRE, "agent");
            asm volatile("s_waitcnt vmcnt(0)" ::: "memory");
        }
    }
    __syncthreads();
}
namespace pg8 {
#define PG8_LAS __attribute__((address_space(3)))
typedef unsigned short bf16_t;
typedef short bf16x8 __attribute__((ext_vector_type(8)));
typedef float f32x4 __attribute__((ext_vector_type(4)));
typedef float f32x2 __attribute__((ext_vector_type(2)));
typedef unsigned u32x4 __attribute__((ext_vector_type(4)));
typedef unsigned u32x2 __attribute__((ext_vector_type(2)));
constexpr int BM = 256, BK = 64, HALF = 128, HTB = HALF * BK * 2  , STAGE_BYTES = 8 * HTB, NXCD = 8, WGM = 8;

__host__ __device__ __forceinline__ int lds_byte(int r, int c) { const int st = (r >> 4) * 2 + (c >> 5), rr = r & 15, cc = c & 31, ob = rr * 64 + cc * 2; return st * 1024 + (ob ^ (((ob >> 9) & 1) << 5)); }
__host__ __device__ __forceinline__ void stage_rc(int b, int& R, int& C) { const int st = b / 1024, sb = b % 1024, swz = sb ^ (((sb >> 9) & 1) << 5); R = (st >> 1) * 16 + swz / 64; C = (st & 1) * 32 + (swz % 64) / 2; }
__host__ __device__ __forceinline__ int perm32(int rho) { const int n = rho >> 4, i = rho & 15; return 8 * (i >> 2) + 4 * n + (i & 3); }

struct Unit { int pm, pn, sub; };
struct Gemm { const bf16_t* A; const bf16_t* Bt; int lda, ldb, K; };

struct StaticOrder {
    int nM, nN, nwg, G, c, nsub;
    __host__ __device__ void init(int M, int N, int G_, int c_, int nsub_ = 1) { nM = M / BM; nN = N / BM; nwg = nM * nN; G = G_; c = c_; nsub = nsub_; }
    __host__ __device__ bool next(int i, Unit& u) const {
        const int it = i / nsub; u.sub = i - it * nsub;
        const long L = (long)it * G + c; if (L >= nwg) return false;
        int wgid = (int)L; { const int q = nwg / NXCD, r = nwg % NXCD, xcd = wgid % NXCD, off = wgid / NXCD; wgid = (xcd < r ? xcd * (q + 1) : r * (q + 1) + (xcd - r) * q) + off; }
        const int nig = WGM * nN, gid = wgid / nig, fm = gid * WGM, gsz = (nM - fm) < WGM ? (nM - fm) : WGM;
        u.pm = fm + ((wgid % nig) % gsz); u.pn = (wgid % nig) / gsz; return true;
    }
};

__device__ __forceinline__ unsigned cvt_pk_bf16(float lo, float hi) { unsigned r; asm volatile("v_cvt_pk_bf16_f32 %0, %1, %2" : "=v"(r) : "v"(lo), "v"(hi)); return r; }
__device__ __forceinline__ float bflo(unsigned w) { return __uint_as_float(w << 16); }
__device__ __forceinline__ float bfhi(unsigned w) { return __uint_as_float(w & 0xffff0000u); }
__device__ __forceinline__ f32x2 gelu_pk(f32x2 v) {
    const f32x2 av = __builtin_elementwise_abs(v), d = av * 0.2316418882f + 1.0f;
    f32x2 t; t.x = __builtin_amdgcn_rcpf(d.x); t.y = __builtin_amdgcn_rcpf(d.y);
    f32x2 q = t * 0.5307027145f + (-0.7265760135f); q = q * t + 0.7107068705f; q = q * t + (-0.142248368f); q = q * t + 0.127414796f; q = q * t;
    const f32x2 s = (v * v) * (-0.72134752044f);
    f32x2 e; e.x = __builtin_amdgcn_exp2f(s.x); e.y = __builtin_amdgcn_exp2f(s.y);
    const f32x2 m = v * (q * e), r = v - m;
    f32x2 o; o.x = v.x < 0.f ? m.x : r.x; o.y = v.y < 0.f ? m.y : r.y; return o;
}

template <class Epi, class Sched, bool ALIGN_EPI>
__device__ __forceinline__ void gemm_phase(PG8_LAS unsigned char* lds, PG8_LAS unsigned char* xlds, const Gemm g, const Sched& S, const Epi& E) {
    int tid_ = threadIdx.x; asm volatile("" : "+v"(tid_));
    const int tid = tid_, wid = __builtin_amdgcn_readfirstlane(tid >> 6), lane = tid & 63, wr = wid >> 2, wc = wid & 3, fr = lane & 15, fq = lane >> 4;
    const int K = g.K, nt = K / BK;
    unsigned voffA[2], voffB[2];
#pragma unroll
    for (int i = 0; i < 2; ++i) { int R, C; stage_rc(tid * 16 + i * 8192, R, C); const int Rb = Epi::PERM ? ((R & ~31) + perm32(R & 31)) : R;
        voffA[i] = (unsigned)(R * g.lda + C) * 2u; voffB[i] = (unsigned)(Rb * g.ldb + C) * 2u; }
    const size_t kstep = (size_t)(BK * 2);
    const size_t hstepA = (size_t)HALF * g.lda * 2, hstepB = (size_t)HALF * g.ldb * 2;
    const size_t tstepA = 2 * hstepA, tstepB = 2 * hstepB, sstep = (size_t)K * 2;
    const unsigned ldsw = (unsigned)wid * 1024u;
    const int aoff = lds_byte(wr * 64 + fr, fq * 8), boff = lds_byte(wc * 32 + fr, fq * 8);
#define PG8_SA(b, h) (((b) * 2 + (h)) * HTB)
#define PG8_SB(b, h) ((4 + (b) * 2 + (h)) * HTB)
#define PG8_STAGE(bufoff, gbase, voff) do { _Pragma("unroll") for (int _i = 0; _i < 2; ++_i) \
        __builtin_amdgcn_global_load_lds((const unsigned*)((const char*)(gbase) + (voff)[_i]), (PG8_LAS unsigned*)(lds + (bufoff) + ldsw + _i * 8192), 16, 0, 0); } while (0)
#define PG8_LDA(dst, b, h) do { _Pragma("unroll") for (int m = 0; m < 4; ++m) _Pragma("unroll") for (int k = 0; k < 2; ++k) dst[m][k] = *(const PG8_LAS bf16x8*)(lds + PG8_SA(b, h) + aoff + m * 2048 + k * 1024); } while (0)
#define PG8_LDB(dst, b, h) do { _Pragma("unroll") for (int n = 0; n < 2; ++n) _Pragma("unroll") for (int k = 0; k < 2; ++k) dst[n][k] = *(const PG8_LAS bf16x8*)(lds + PG8_SB(b, h) + boff + n * 2048 + k * 1024); } while (0)
#define PG8_MMA(ai, bj, At, Bt) do { __builtin_amdgcn_s_setprio(1); _Pragma("unroll") for (int m = 0; m < 4; ++m) _Pragma("unroll") for (int n = 0; n < 2; ++n) _Pragma("unroll") for (int k = 0; k < 2; ++k) \
        acc[ai][bj][m][n] = __builtin_amdgcn_mfma_f32_16x16x32_bf16(Bt[n][k], At[m][k], acc[ai][bj][m][n], 0, 0, 0); __builtin_amdgcn_s_setprio(0); } while (0)
#define PG8_WAIT_V(n) asm volatile("s_waitcnt vmcnt(" #n ")" ::: "memory")
#define PG8_WAIT_L(n) asm volatile("s_waitcnt lgkmcnt(" #n ")" ::: "memory")
#define PG8_BAR __builtin_amdgcn_s_barrier()
#define PG8_SCHED __builtin_amdgcn_sched_barrier(0)
    Unit cur, nxt; int ui = 0;
    if (!S.next(0, cur)) return;
    f32x4 acc[2][2][4][2];
#pragma unroll
    for (int a = 0; a < 2; ++a)
#pragma unroll
        for (int b = 0; b < 2; ++b)
#pragma unroll
            for (int m = 0; m < 4; ++m)
#pragma unroll
                for (int n = 0; n < 2; ++n) acc[a][b][m][n] = (f32x4){0.f, 0.f, 0.f, 0.f};
    bf16x8 At[4][2], B0[2][2], B1[2][2];
    const char* cA = (const char*)g.A + (size_t)cur.pm * tstepA + (size_t)cur.sub * sstep; const char* cB = (const char*)g.Bt + (size_t)cur.pn * tstepB + (size_t)cur.sub * sstep;
    PG8_STAGE(PG8_SB(0, 0), cB, voffB); PG8_STAGE(PG8_SB(0, 1), cB + hstepB, voffB); PG8_STAGE(PG8_SA(0, 0), cA, voffA); PG8_STAGE(PG8_SA(0, 1), cA + hstepA, voffA);
    if (wr == 1) PG8_BAR;
    PG8_WAIT_V(2); PG8_BAR;
    PG8_STAGE(PG8_SB(1, 0), cB + kstep, voffB); PG8_STAGE(PG8_SA(1, 0), cA + kstep, voffA); PG8_STAGE(PG8_SB(1, 1), cB + hstepB + kstep, voffB);
    PG8_WAIT_V(6); PG8_BAR;
    for (;;) {
        const bool has_next = S.next(ui + 1, nxt);
        const char* nA = has_next ? (const char*)g.A + (size_t)nxt.pm * tstepA + (size_t)nxt.sub * sstep : cA; const char* nB = has_next ? (const char*)g.Bt + (size_t)nxt.pn * tstepB + (size_t)nxt.sub * sstep : cB;
        for (int t = 0; t < nt; t += 2) {
            const bool last = (t == nt - 2);
            const char* a1 = cA + (size_t)(t + 1) * kstep;
            const char* a2 = last ? nA : cA + (size_t)(t + 2) * kstep; const char* b2 = last ? nB : cB + (size_t)(t + 2) * kstep;
            const char* a3 = a2 + kstep; const char* b3 = b2 + kstep;
            PG8_LDB(B0, 0, 0); PG8_LDB(B1, 0, 1); PG8_SCHED; PG8_LDA(At, 0, 0); PG8_STAGE(PG8_SA(1, 1), a1 + hstepA, voffA);
            PG8_WAIT_V(8); PG8_WAIT_L(0); PG8_BAR; PG8_MMA(0, 0, At, B0); PG8_MMA(0, 1, At, B1); PG8_BAR; PG8_SCHED;
            PG8_LDA(At, 0, 1); PG8_STAGE(PG8_SB(0, 0), b2, voffB); PG8_STAGE(PG8_SB(0, 1), b2 + hstepB, voffB); PG8_STAGE(PG8_SA(0, 0), a2, voffA);
            PG8_WAIT_V(8); PG8_WAIT_L(0); PG8_BAR; PG8_MMA(1, 0, At, B0); PG8_MMA(1, 1, At, B1); PG8_BAR; PG8_SCHED;
            PG8_LDB(B0, 1, 0); PG8_LDB(B1, 1, 1); PG8_SCHED; PG8_LDA(At, 1, 0); PG8_STAGE(PG8_SA(0, 1), a2 + hstepA, voffA);
            PG8_WAIT_V(8); PG8_WAIT_L(0); PG8_BAR; PG8_MMA(0, 0, At, B0); PG8_MMA(0, 1, At, B1); PG8_BAR; PG8_SCHED;
            PG8_LDA(At, 1, 1); PG8_STAGE(PG8_SB(1, 0), b3, voffB); PG8_STAGE(PG8_SB(1, 1), b3 + hstepB, voffB); PG8_STAGE(PG8_SA(1, 0), a3, voffA);
            PG8_WAIT_V(8); PG8_WAIT_L(0); PG8_BAR; PG8_MMA(1, 0, At, B0); PG8_MMA(1, 1, At, B1); PG8_BAR; PG8_SCHED;
        }
        if constexpr (ALIGN_EPI) { if (wr == 0) PG8_BAR; }
        bool keep = false;
        int efr = fr, efq = fq; asm volatile("" : "+v"(efr), "+v"(efq));
        if constexpr (Epi::HAS_MID) { if (cur.sub + 1 < S.nsub) { E.mid(acc, cur, wr, wc, efr, efq, xlds); keep = true; } }
        if (!keep) E.fin(acc, cur, wr, wc, efr, efq, xlds);
        if (!has_next) break;
        if (!keep) {
#pragma unroll
        for (int a = 0; a < 2; ++a)
#pragma unroll
            for (int b = 0; b < 2; ++b)
#pragma unroll
                for (int m = 0; m < 4; ++m)
#pragma unroll
                    for (int n = 0; n < 2; ++n) acc[a][b][m][n] = (f32x4){0.f, 0.f, 0.f, 0.f};
        }
        cur = nxt; cA = nA; cB = nB; ++ui;
        if constexpr (ALIGN_EPI) { if (wr == 1) PG8_BAR; }
    }
    PG8_WAIT_V(0);
    if constexpr (!ALIGN_EPI) { if (wr == 0) PG8_BAR; }
    PG8_BAR;
#undef PG8_SA
#undef PG8_SB
#undef PG8_STAGE
#undef PG8_LDA
#undef PG8_LDB
#undef PG8_MMA
#undef PG8_WAIT_V
#undef PG8_WAIT_L
#undef PG8_BAR
#undef PG8_SCHED
}
}
namespace pg8 {
struct EpiU {
    static constexpr bool PERM = true, HAS_MID = false;
    bf16_t *QA, *KVA, *QB, *KB, *VB, *GATES; const float* bias; const float* qnorm; const float* knorm; const float* rope;
    __device__ __forceinline__ void fin_rope(f32x4 (&acc)[2][2][4][2], const Unit& u, int wr, int wc, int fr, int fq, PG8_LAS unsigned char* xlds) const {
        PG8_LAS float* part = (PG8_LAS float*)xlds;
        const int pn = u.pn, L = 4 * wc + fq, d1 = (L < 8) ? 4 * L : 4 * L + 32, row0 = u.pm * BM + wr * 64 + fr, rl0 = wr * 64 + fr;
        const float* sc = (pn < 5) ? qnorm : knorm;
        f32x4 b1v[2], b2v[2];
#pragma unroll
        for (int bj = 0; bj < 2; ++bj) { b1v[bj] = *(const f32x4*)(bias + pn * BM + bj * HALF + d1); b2v[bj] = *(const f32x4*)(bias + pn * BM + bj * HALF + d1 + 32); }
        const f32x4 s1 = *(const f32x4*)(sc + d1), s2 = *(const f32x4*)(sc + d1 + 32);
#pragma unroll
        for (int ai = 0; ai < 2; ++ai)
#pragma unroll
            for (int m = 0; m < 4; ++m)
#pragma unroll
                for (int bj = 0; bj < 2; ++bj) { const f32x4 v0 = acc[ai][bj][m][0] + b1v[bj], v1 = acc[ai][bj][m][1] + b2v[bj]; acc[ai][bj][m][0] = v0; acc[ai][bj][m][1] = v1;
                    float ss = (v0[0] * v0[0] + v0[1] * v0[1]) + (v0[2] * v0[2] + v0[3] * v0[3]) + (v1[0] * v1[0] + v1[1] * v1[1]) + (v1[2] * v1[2] + v1[3] * v1[3]);
                    ss += __shfl_xor(ss, 16); ss += __shfl_xor(ss, 32);
                    if (fq == 0) part[((rl0 + ai * HALF + m * 16) * 2 + bj) * 4 + wc] = ss; }
        asm volatile("s_waitcnt lgkmcnt(0)" ::: "memory"); __builtin_amdgcn_s_barrier(); asm volatile("" ::: "memory");
        bf16_t* base = (pn < 5) ? QB + (pn - 3) * 256 : KB; const int ldc = (pn < 5) ? 512 : 256;
#pragma unroll
        for (int ai = 0; ai < 2; ++ai)
#pragma unroll
            for (int m = 0; m < 4; ++m) { const int r = row0 + ai * HALF + m * 16, ts = r & 4095, pos = (L < 8) ? (ts >> 6) : (ts & 63);
                const float* tp = rope + (pos * 32 + ((4 * L) & 31)) * 2;
                const f32x4 t0 = *(const f32x4*)tp, t1 = *(const f32x4*)(tp + 4);
                const float cs[4] = {t0[0], t0[2], t1[0], t1[2]}, sn[4] = {t0[1], t0[3], t1[1], t1[3]};
#pragma unroll
                for (int bj = 0; bj < 2; ++bj) { const f32x4 pr = *(const PG8_LAS f32x4*)(part + ((rl0 + ai * HALF + m * 16) * 2 + bj) * 4);
                    const float rstd = 1.0f / sqrtf(((pr[0] + pr[1]) + (pr[2] + pr[3])) * (1.0f / 128.0f) + 1e-6f);
                    const f32x4 y1 = acc[ai][bj][m][0] * rstd * s1, y2 = acc[ai][bj][m][1] * rstd * s2; f32x4 o1, o2;
#pragma unroll
                    for (int j = 0; j < 4; ++j) { o1[j] = y1[j] * cs[j] - y2[j] * sn[j]; o2[j] = y1[j] * sn[j] + y2[j] * cs[j]; }
                    bf16_t* op = base + (size_t)r * ldc + bj * HALF + d1;
                    u32x2 w1, w2; w1.x = cvt_pk_bf16(o1[0], o1[1]); w1.y = cvt_pk_bf16(o1[2], o1[3]); w2.x = cvt_pk_bf16(o2[0], o2[1]); w2.y = cvt_pk_bf16(o2[2], o2[3]);
                    *(u32x2*)op = w1; *(u32x2*)(op + 32) = w2; } }
    }
    __device__ __forceinline__ void mid(f32x4 (&)[2][2][4][2], const Unit&, int, int, int, int, PG8_LAS unsigned char*) const {}
    __device__ __forceinline__ void fin(f32x4 (&acc)[2][2][4][2], const Unit& u, int wr, int wc, int fr, int fq, PG8_LAS unsigned char* xlds) const {
#ifdef ABL_P1_NOEPI
        if (u.pn >= 0) { asm volatile("" :: "v"(acc[0][0][0][0]), "v"(acc[1][1][3][1])); return; }
#endif
        const int pn = u.pn; bf16_t* base; int ldc, colt; bool sig = false;
        if (pn >= 3 && pn <= 5) { fin_rope(acc, u, wr, wc, fr, fq, xlds); return; }
        if (pn < 2) { base = QA; ldc = 512; colt = pn * 256; }
        else if (pn == 2) { base = KVA; ldc = 256; colt = 0; }
        else if (pn < 5) { base = QB; ldc = 512; colt = (pn - 3) * 256; }
        else if (pn == 5) { base = KB; ldc = 256; colt = 0; }
        else if (pn == 6) { base = VB; ldc = 256; colt = 0; }
        else { base = GATES; ldc = 2048; colt = (pn - 7) * 256; sig = true; }
        const int row0 = u.pm * BM + wr * 64 + fr;
        const int col0 = colt + wc * 32 + 8 * fq, bcol0 = pn * BM + wc * 32 + 8 * fq;
        f32x4 bv[2][2];
#pragma unroll
        for (int bj = 0; bj < 2; ++bj)
#pragma unroll
            for (int n = 0; n < 2; ++n) {
#ifdef ABL_P1_NOBIAS
                bv[bj][n] = (f32x4){0.f, 0.f, 0.f, 0.f};
#else
                bv[bj][n] = *(const f32x4*)(bias + bcol0 + bj * HALF + 4 * n);
#endif
            }
#pragma unroll
        for (int ai = 0; ai < 2; ++ai)
#pragma unroll
            for (int m = 0; m < 4; ++m) { bf16_t* rowp = base + (size_t)(row0 + ai * HALF + m * 16) * ldc + col0;
#pragma unroll
                for (int bj = 0; bj < 2; ++bj) { f32x4 v0 = acc[ai][bj][m][0] + bv[bj][0], v1 = acc[ai][bj][m][1] + bv[bj][1];
                    if (sig) {
#pragma unroll
                        for (int j = 0; j < 4; ++j) { v0[j] = fmaxf(__builtin_amdgcn_rcpf(1.0f + __builtin_amdgcn_exp2f(-1.4426950408889634f * v0[j])), 1e-20f);
                                                      v1[j] = fmaxf(__builtin_amdgcn_rcpf(1.0f + __builtin_amdgcn_exp2f(-1.4426950408889634f * v1[j])), 1e-20f); } }
                    u32x4 w; w.x = cvt_pk_bf16(v0[0], v0[1]); w.y = cvt_pk_bf16(v0[2], v0[3]); w.z = cvt_pk_bf16(v1[0], v1[1]); w.w = cvt_pk_bf16(v1[2], v1[3]);
                    *(u32x4*)(rowp + bj * HALF) = w; } }
    }
};

struct EpiGate {
    static constexpr bool PERM = true, HAS_MID = true;
    const bf16_t* GATES; bf16_t* OUT;
    __device__ __forceinline__ void mid(f32x4 (&acc)[2][2][4][2], const Unit& u, int wr, int wc, int fr, int fq, PG8_LAS unsigned char*) const {
        const int row0 = u.pm * BM + wr * 64 + fr, col0 = u.pn * BM + wc * 32 + 8 * fq;
#pragma unroll
        for (int ai = 0; ai < 2; ++ai)
#pragma unroll
            for (int m = 0; m < 4; ++m) { const bf16_t* gp = GATES + (size_t)(row0 + ai * HALF + m * 16) * 2048 + col0;
#pragma unroll
                for (int bj = 0; bj < 2; ++bj) { const u32x4 a = *(const u32x4*)(gp + bj * HALF), b = *(const u32x4*)(gp + 1024 + bj * HALF);
                    f32x4 r0, r1;
                    r0[0] = bflo(a.x) * __builtin_amdgcn_rcpf(bflo(b.x)); r0[1] = bfhi(a.x) * __builtin_amdgcn_rcpf(bfhi(b.x));
                    r0[2] = bflo(a.y) * __builtin_amdgcn_rcpf(bflo(b.y)); r0[3] = bfhi(a.y) * __builtin_amdgcn_rcpf(bfhi(b.y));
                    r1[0] = bflo(a.z) * __builtin_amdgcn_rcpf(bflo(b.z)); r1[1] = bfhi(a.z) * __builtin_amdgcn_rcpf(bfhi(b.z));
                    r1[2] = bflo(a.w) * __builtin_amdgcn_rcpf(bflo(b.w)); r1[3] = bfhi(a.w) * __builtin_amdgcn_rcpf(bfhi(b.w));
                    acc[ai][bj][m][0] = acc[ai][bj][m][0] * r0; acc[ai][bj][m][1] = acc[ai][bj][m][1] * r1; } }
    }
    __device__ __forceinline__ void fin(f32x4 (&acc)[2][2][4][2], const Unit& u, int wr, int wc, int fr, int fq, PG8_LAS unsigned char*) const {
        const int row0 = u.pm * BM + wr * 64 + fr, col0 = u.pn * BM + wc * 32 + 8 * fq;
#pragma unroll
        for (int ai = 0; ai < 2; ++ai)
#pragma unroll
            for (int m = 0; m < 4; ++m) { const size_t r = (size_t)(row0 + ai * HALF + m * 16); const bf16_t* gp = GATES + r * 2048 + 1024 + col0; bf16_t* op = OUT + r * 1024 + col0;
#pragma unroll
                for (int bj = 0; bj < 2; ++bj) { const u32x4 b = *(const u32x4*)(gp + bj * HALF);
                    const f32x4 v0 = acc[ai][bj][m][0], v1 = acc[ai][bj][m][1];
                    u32x4 w; w.x = cvt_pk_bf16(v0[0] * bflo(b.x), v0[1] * bfhi(b.x)); w.y = cvt_pk_bf16(v0[2] * bflo(b.y), v0[3] * bfhi(b.y));
                    w.z = cvt_pk_bf16(v1[0] * bflo(b.z), v1[1] * bfhi(b.z)); w.w = cvt_pk_bf16(v1[2] * bflo(b.w), v1[3] * bfhi(b.w));
                    *(u32x4*)(op + bj * HALF) = w; } }
    }
};

constexpr float FX_SCALE = 1099511627776.0f, FX_INV = 1.0f / 1099511627776.0f;
__device__ __forceinline__ void fx_stats(const long long* rs, unsigned row, float eps, float& mean, float& rstd) {
    const long long s = rs[2u * row], q = rs[2u * row + 1u];
    mean = (float)s * (FX_INV / 1024.0f); const float var = (float)q * (FX_INV / 1024.0f) - mean * mean; rstd = 1.0f / sqrtf(var + eps);
}
template <bool FIRST> struct EpiRes {
    static constexpr bool PERM = false, HAS_MID = false;
    const float* src; const f32x2* stat; const long long* RSin; const float* g; const float* b; float* out; long long* RSout; const float* gz; bf16_t* ZB;
    static constexpr float alpha = 1.189207115002721f;
    __device__ __forceinline__ void mid(f32x4 (&)[2][2][4][2], const Unit&, int, int, int, int, PG8_LAS unsigned char*) const {}
    __device__ __forceinline__ void fin(f32x4 (&acc)[2][2][4][2], const Unit& u, int wr, int wc, int fr, int fq, PG8_LAS unsigned char*) const {
        const int row0 = u.pm * BM + wr * 64 + fr, col0 = u.pn * BM + wc * 32 + 4 * fq;
        f32x4 gv[2][2], bv[2][2], gzv[2][2];
#pragma unroll
        for (int bj = 0; bj < 2; ++bj)
#pragma unroll
            for (int n = 0; n < 2; ++n) { gv[bj][n] = *(const f32x4*)(g + col0 + bj * HALF + n * 16) * alpha; bv[bj][n] = *(const f32x4*)(b + col0 + bj * HALF + n * 16) * alpha;
                if (FIRST) gzv[bj][n] = *(const f32x4*)(gz + col0 + bj * HALF + n * 16); }
#pragma unroll
        for (int ai = 0; ai < 2; ++ai)
#pragma unroll
            for (int m = 0; m < 4; ++m) { const size_t r = (size_t)(row0 + ai * HALF + m * 16); const size_t off = r * 1024 + col0;
                float mu, rs; if (FIRST) { const f32x2 st = stat[r]; mu = st.x; rs = st.y; } else fx_stats(RSin, (unsigned)r, 1e-5f, mu, rs);
                float ssum = 0.f, qsum = 0.f;
#pragma unroll
                for (int bj = 0; bj < 2; ++bj)
#pragma unroll
                    for (int n = 0; n < 2; ++n) { const f32x4 x = *(const f32x4*)(src + off + bj * HALF + n * 16);
                        const f32x4 o = ((x - mu) * rs) * gv[bj][n] + bv[bj][n] + acc[ai][bj][m][n];
                        *(f32x4*)(out + off + bj * HALF + n * 16) = o;
                        ssum += (o[0] + o[1]) + (o[2] + o[3]); qsum += (o[0] * o[0] + o[1] * o[1]) + (o[2] * o[2] + o[3] * o[3]);
                        if (FIRST) { const f32x4 zb = o * gzv[bj][n]; u32x2 w; w.x = cvt_pk_bf16(zb[0], zb[1]); w.y = cvt_pk_bf16(zb[2], zb[3]); *(u32x2*)(ZB + off + bj * HALF + n * 16) = w; } }
                ssum += __shfl_xor(ssum, 16); ssum += __shfl_xor(ssum, 32); qsum += __shfl_xor(qsum, 16); qsum += __shfl_xor(qsum, 32);
                if (fq == 0) { atomicAdd((unsigned long long*)RSout + 2 * r, (unsigned long long)__float2ll_rn(ssum * FX_SCALE)); atomicAdd((unsigned long long*)RSout + 2 * r + 1, (unsigned long long)__float2ll_rn(qsum * FX_SCALE)); }
                if (m & 1) asm volatile("" ::: "memory"); }
    }
};

__device__ __forceinline__ float dpp_ror1(float v)  { return __builtin_bit_cast(float, __builtin_amdgcn_update_dpp(0, __builtin_bit_cast(int, v), 0x121, 0xF, 0xF, false)); }
__device__ __forceinline__ float dpp_ror15(float v) { return __builtin_bit_cast(float, __builtin_amdgcn_update_dpp(0, __builtin_bit_cast(int, v), 0x12F, 0xF, 0xF, false)); }
struct EpiFfnUp {
    static constexpr bool PERM = true, HAS_MID = false;
    bf16_t* ACT; const float* cw; const float* cb; float* Pb; float* Gb; float* Vb; const long long* RS; const float* C1; const float* C2;
    __device__ __forceinline__ void mid(f32x4 (&)[2][2][4][2], const Unit&, int, int, int, int, PG8_LAS unsigned char*) const {}
    __device__ __forceinline__ void fin(f32x4 (&acc)[2][2][4][2], const Unit& u, int wr, int wc, int fr, int fq, PG8_LAS unsigned char* xlds) const {
        constexpr int FF = 2816;
        PG8_LAS float* halo = (PG8_LAS float*)xlds;
        const int cl = wc * 32 + 8 * fq, ch0 = u.pn * HALF + cl;
        const int row0 = u.pm * BM + wr * 64 + fr;
#ifndef ABL_NOCORR
        {
            typedef long long i64x2 __attribute__((ext_vector_type(2)));
            i64x2 rsv[2][4];
#pragma unroll
            for (int ai = 0; ai < 2; ++ai)
#pragma unroll
                for (int m = 0; m < 4; ++m) {
#ifdef ABL_NOLOADS
                    rsv[ai][m] = (i64x2){(long long)(row0 + m), 1099511627776ll * 1500ll};
#else
                    rsv[ai][m] = *(const i64x2*)(RS + 2u * (unsigned)(row0 + ai * HALF + m * 16));
#endif
                }
            f32x4 c1[2][2], c2[2][2];
#pragma unroll
            for (int bj = 0; bj < 2; ++bj)
#pragma unroll
                for (int n = 0; n < 2; ++n) {
#ifdef ABL_NOLOADS
                    c1[bj][n] = (f32x4){0.1f, 0.2f, 0.3f, 0.4f} * (float)(cl & 3); c2[bj][n] = (f32x4){0.4f, 0.3f, 0.2f, 0.1f} * (float)(cl & 1);
#else
                    c1[bj][n] = *(const f32x4*)(C1 + u.pn * BM + bj * HALF + cl + 4 * n); c2[bj][n] = *(const f32x4*)(C2 + u.pn * BM + bj * HALF + cl + 4 * n);
#endif
                }
#pragma unroll
            for (int ai = 0; ai < 2; ++ai)
#pragma unroll
                for (int m = 0; m < 4; ++m) {
                    const float mu = (float)rsv[ai][m].x * (FX_INV / 1024.0f), var = (float)rsv[ai][m].y * (FX_INV / 1024.0f) - mu * mu, rs = 1.0f / sqrtf(var + 1e-5f);
#pragma unroll
                    for (int bj = 0; bj < 2; ++bj)
#pragma unroll
                        for (int n = 0; n < 2; ++n) acc[ai][bj][m][n] = (acc[ai][bj][m][n] - c1[bj][n] * mu) * rs + c2[bj][n];
                    asm volatile("" : "+v"(acc[ai][0][m][0]), "+v"(acc[ai][0][m][1]), "+v"(acc[ai][1][m][0]), "+v"(acc[ai][1][m][1]));
                }
        }
#endif
        asm volatile("" ::: "memory");
        f32x4 w0[2], w1[2], w2[2], cbv[2];
#pragma unroll
        for (int n = 0; n < 2; ++n) {
#ifdef ABL_NOLOADS
            w0[n] = (f32x4){0.1f, 0.2f, 0.3f, 0.4f} * (float)(1 + (ch0 & 1)); w1[n] = w0[n] * 0.5f; w2[n] = w0[n] * 0.25f; cbv[n] = w0[n] * 0.125f;
#else
            w0[n] = *(const f32x4*)(cw + ch0 + 4 * n); w1[n] = *(const f32x4*)(cw + FF + ch0 + 4 * n); w2[n] = *(const f32x4*)(cw + 2 * FF + ch0 + 4 * n); cbv[n] = *(const f32x4*)(cb + ch0 + 4 * n);
#endif
        }
#pragma unroll
        for (int ai = 0; ai < 2; ++ai) { const int s = 2 * ai + wr;
            if (fr == 0)  { *(PG8_LAS f32x4*)(halo + (s * 2 + 0) * HALF + cl) = acc[ai][0][0][0]; *(PG8_LAS f32x4*)(halo + (s * 2 + 0) * HALF + cl + 4) = acc[ai][0][0][1]; }
            if (fr == 15) { *(PG8_LAS f32x4*)(halo + (s * 2 + 1) * HALF + cl) = acc[ai][0][3][0]; *(PG8_LAS f32x4*)(halo + (s * 2 + 1) * HALF + cl + 4) = acc[ai][0][3][1]; } }
        asm volatile("s_waitcnt lgkmcnt(0)" ::: "memory"); __builtin_amdgcn_s_barrier(); asm volatile("" ::: "memory");
#pragma unroll
        for (int ai = 0; ai < 2; ++ai) { const int s = 2 * ai + wr;
            f32x4 upsrc[2], dnh[2], Lc[2];
            if (s > 0) { upsrc[0] = *(const PG8_LAS f32x4*)(halo + ((s - 1) * 2 + 1) * HALF + cl); upsrc[1] = *(const PG8_LAS f32x4*)(halo + ((s - 1) * 2 + 1) * HALF + cl + 4); }
            else { upsrc[0] = (f32x4){0.f, 0.f, 0.f, 0.f}; upsrc[1] = upsrc[0]; }
            if (s < 3) { dnh[0] = *(const PG8_LAS f32x4*)(halo + ((s + 1) * 2 + 0) * HALF + cl); dnh[1] = *(const PG8_LAS f32x4*)(halo + ((s + 1) * 2 + 0) * HALF + cl + 4); }
            else { dnh[0] = (f32x4){0.f, 0.f, 0.f, 0.f}; dnh[1] = dnh[0]; }
#pragma unroll
            for (int n = 0; n < 2; ++n)
#pragma unroll
                for (int j = 0; j < 4; ++j) Lc[n][j] = dpp_ror15(acc[ai][0][0][n][j]);
#pragma unroll
            for (int m = 0; m < 4; ++m) {
                f32x4 cv[2];
#pragma unroll
                for (int n = 0; n < 2; ++n)
#pragma unroll
                    for (int j = 0; j < 4; ++j) {
                        const float gc = acc[ai][0][m][n][j];
                        const float R = dpp_ror1(gc);
                        const float Ln = (m < 3) ? dpp_ror15(acc[ai][0][m < 3 ? m + 1 : 3][n][j]) : dnh[n][j];
                        const float up = (fr == 0) ? upsrc[n][j] : R;
                        const float dn = (fr == 15) ? Ln : Lc[n][j];
                        upsrc[n][j] = R; Lc[n][j] = Ln;
                        cv[n][j] = w0[n][j] * up + w1[n][j] * gc + w2[n][j] * dn + cbv[n][j];
                    }
                const unsigned r = (unsigned)(row0 + ai * HALF + m * 16);
                if ((ai == 0 && m == 0) || (ai == 1 && m == 3)) {
                    const bool first = (ai == 0 && m == 0);
                    if (first ? (wr == 0 && fr == 0) : (wr == 1 && fr == 15)) {
                        const size_t bo = ((size_t)u.pm * 2 + (first ? 0 : 1)) * FF + ch0;
#pragma unroll
                        for (int n = 0; n < 2; ++n) { *(f32x4*)(Pb + bo + 4 * n) = cv[n]; *(f32x4*)(Gb + bo + 4 * n) = acc[ai][0][m][n]; *(f32x4*)(Vb + bo + 4 * n) = acc[ai][1][m][n]; }
                    }
                }
                f32x4 o[2];
#pragma unroll
                for (int n = 0; n < 2; ++n) {
#ifdef ABL_NOGELU
                    const f32x2 a = (f32x2){cv[n][0], cv[n][1]}, b = (f32x2){cv[n][2], cv[n][3]};
#else
                    const f32x2 a = gelu_pk((f32x2){cv[n][0], cv[n][1]}), b = gelu_pk((f32x2){cv[n][2], cv[n][3]});
#endif
                    o[n] = (f32x4){a.x, a.y, b.x, b.y} * acc[ai][1][m][n]; }
                u32x4 w; w.x = cvt_pk_bf16(o[0][0], o[0][1]); w.y = cvt_pk_bf16(o[0][2], o[0][3]); w.z = cvt_pk_bf16(o[1][0], o[1][1]); w.w = cvt_pk_bf16(o[1][2], o[1][3]);
                *(u32x4*)(ACT + (unsigned)(r * (unsigned)FF + (unsigned)ch0)) = w;
            }
        }
    }
};
}
namespace attn {
using bf16x8 = __attribute__((ext_vector_type(8))) short;
using s16x4  = __attribute__((ext_vector_type(4))) short;
using f32x16 = __attribute__((ext_vector_type(16))) float;
using u32x4  = __attribute__((ext_vector_type(4))) unsigned;
typedef unsigned short bf16_t;
constexpr int NW = 8, QBLK = 32, KVBLK = 64;
#define KSWZ(row, colB) ((row) * 256 + ((colB) ^ (((row) & 7) << 4)))
#define SBAR() __builtin_amdgcn_sched_barrier(0)
__device__ __forceinline__ int crow(int r, int hi) { return (r & 3) + 8 * (r >> 2) + 4 * hi; }
__device__ __forceinline__ unsigned cvtpk(float lo, float hi) { unsigned r; asm volatile("v_cvt_pk_bf16_f32 %0, %1, %2" : "=v"(r) : "v"(lo), "v"(hi)); return r; }
__device__ __forceinline__ unsigned short f2bf_s(float f) { unsigned u = __float_as_uint(f); return (unsigned short)((u + 0x7fffu + ((u >> 16) & 1u)) >> 16); }
template <int OFF> __device__ __forceinline__ s16x4 tr_read(int vb) { s16x4 r; asm volatile("ds_read_b64_tr_b16 %0, %1 offset:%2" : "=&v"(r) : "v"(vb), "i"(OFF) : "memory"); return r; }
__device__ __forceinline__ int v_rd_base(int lane) { return ((lane & 3) << 3) | (((lane >> 2) & 3) << 6) | (((lane >> 4) & 1) << 5) | (((lane >> 5) & 1) << 8); }
#define PK4(P, BASE, OUT) do { unsigned a0 = cvtpk(P[BASE + 0], P[BASE + 1]), a1 = cvtpk(P[BASE + 2], P[BASE + 3]);   \
    unsigned b0 = cvtpk(P[BASE + 4], P[BASE + 5]), b1 = cvtpk(P[BASE + 6], P[BASE + 7]);                              \
    auto r0 = __builtin_amdgcn_permlane32_swap(a0, b0, false, false); auto r1 = __builtin_amdgcn_permlane32_swap(a1, b1, false, false); \
    u32x4 w = {r0[0], r1[0], r0[1], r1[1]}; OUT = *reinterpret_cast<bf16x8*>(&w); } while (0)
#define PKF(L, H) (bf16x8){L[0], L[1], L[2], L[3], H[0], H[1], H[2], H[3]}

namespace dense {
constexpr int D = 128;
constexpr float SCALE = 0.088388347648318440f;
constexpr float THR = 8.f;
constexpr int LDQ = 512, LDK = 256, LDO = 1024;
constexpr size_t SHM_V = KVBLK * D * 2, SHM_K = KVBLK * D * 2, SHM_ATTN = 2 * SHM_V + 2 * SHM_K + NW * 64 * 4;
__device__ __forceinline__ void partialSM(f32x16& p0, f32x16& p1, float& m_reg, float& mn, float& alpha) {
  constexpr float C = SCALE * 1.4426950408889634f;
  float pmax = p0[0]; for (int r = 1; r < 16; ++r) pmax = fmaxf(pmax, p0[r]); for (int r = 0; r < 16; ++r) pmax = fmaxf(pmax, p1[r]);
  { auto rr = __builtin_amdgcn_permlane32_swap(__float_as_uint(pmax), __float_as_uint(pmax), false, false);
    pmax = fmaxf(__uint_as_float(rr[0]), __uint_as_float(rr[1])); }
  if (__builtin_expect(__all(pmax - m_reg <= THR / SCALE), 1)) { mn = m_reg; alpha = 1.f; }
  else { mn = fmaxf(m_reg, pmax); alpha = __builtin_amdgcn_exp2f((m_reg - mn) * C); m_reg = mn; }
  float mnC = -mn * C;
  for (int r = 0; r < 16; ++r) p0[r] = fmaf(p0[r], C, mnC); for (int r = 0; r < 16; ++r) p1[r] = fmaf(p1[r], C, mnC);
  for (int r = 0; r < 16; ++r) p0[r] = __builtin_amdgcn_exp2f(p0[r]);
}
__device__ __forceinline__ void finishSM(f32x16& p0, f32x16& p1, float alpha, float& l_reg, bf16x8& pa0, bf16x8& pa1, bf16x8& pa2, bf16x8& pa3) {
  for (int r = 0; r < 16; ++r) p1[r] = __builtin_amdgcn_exp2f(p1[r]);
  float ps = 0; for (int r = 0; r < 16; ++r) ps += p0[r]; for (int r = 0; r < 16; ++r) ps += p1[r];
  { auto rr = __builtin_amdgcn_permlane32_swap(__float_as_uint(ps), __float_as_uint(ps), false, false);
    ps = __uint_as_float(rr[0]) + __uint_as_float(rr[1]); }
  l_reg = l_reg * alpha + ps;
  PK4(p0, 0, pa0); PK4(p0, 8, pa1); PK4(p1, 0, pa2); PK4(p1, 8, pa3);
}
__device__ __forceinline__ void qkt(f32x16& p0, f32x16& p1, const bf16_t* Ks, const bf16x8* qr, int r32, int hi) {
  p0 = f32x16{}; p1 = f32x16{};
  for (int d0 = 0; d0 < 8; ++d0) { int cb = (d0 * 16 + hi * 8) * 2;
    bf16x8 b0 = *reinterpret_cast<const bf16x8*>((const char*)Ks + KSWZ(r32, cb));
    bf16x8 b1 = *reinterpret_cast<const bf16x8*>((const char*)Ks + KSWZ(32 + r32, cb));
    p0 = __builtin_amdgcn_mfma_f32_32x32x16_bf16(b0, qr[d0], p0, 0, 0, 0);
    p1 = __builtin_amdgcn_mfma_f32_32x32x16_bf16(b1, qr[d0], p1, 0, 0, 0); }
}
__device__ __forceinline__ int v_st(int k, int c) { const int kk = (k & ~0xC) | ((k & 4) << 1) | ((k & 8) >> 1); return ((kk >> 3) * 4 + (c >> 5)) * 512 + ((kk & 7) * 32 + (c & 31)) * 2; }
constexpr int v_rd_off(int d0, int ks, int half) { return d0 * 512 + ks * 4096 + half * 2048; }
template <int D0> __device__ __forceinline__ void pv_one(f32x16& od, int vb, bf16x8 pa0, bf16x8 pa1, bf16x8 pa2, bf16x8 pa3) {
  const s16x4 l0 = tr_read<v_rd_off(D0, 0, 0)>(vb), h0 = tr_read<v_rd_off(D0, 0, 1)>(vb), l1 = tr_read<v_rd_off(D0, 1, 0)>(vb), h1 = tr_read<v_rd_off(D0, 1, 1)>(vb);
  const s16x4 l2 = tr_read<v_rd_off(D0, 2, 0)>(vb), h2 = tr_read<v_rd_off(D0, 2, 1)>(vb), l3 = tr_read<v_rd_off(D0, 3, 0)>(vb), h3 = tr_read<v_rd_off(D0, 3, 1)>(vb);
  asm volatile("s_waitcnt lgkmcnt(0)" ::: "memory"); SBAR();
  od = __builtin_amdgcn_mfma_f32_32x32x16_bf16(pa0, PKF(l0, h0), od, 0, 0, 0);
  od = __builtin_amdgcn_mfma_f32_32x32x16_bf16(pa1, PKF(l1, h1), od, 0, 0, 0);
  od = __builtin_amdgcn_mfma_f32_32x32x16_bf16(pa2, PKF(l2, h2), od, 0, 0, 0);
  od = __builtin_amdgcn_mfma_f32_32x32x16_bf16(pa3, PKF(l3, h3), od, 0, 0, 0);
}
__device__ __forceinline__ void pv_d0(f32x16* o, int vb, bf16x8 pa0, bf16x8 pa1, bf16x8 pa2, bf16x8 pa3) {
  pv_one<0>(o[0], vb, pa0, pa1, pa2, pa3); pv_one<1>(o[1], vb, pa0, pa1, pa2, pa3); pv_one<2>(o[2], vb, pa0, pa1, pa2, pa3); pv_one<3>(o[3], vb, pa0, pa1, pa2, pa3);
}
__device__ __forceinline__ void body(const bf16_t* __restrict__ Qb, const bf16_t* __restrict__ Kh, const bf16_t* __restrict__ Vh, bf16_t* __restrict__ Ob, int seq, char* lds) {
  int tid_ = threadIdx.x; asm volatile("" : "+v"(tid_));
  const int tid = tid_, wid = tid >> 6, lane = tid & 63, r32 = lane & 31, hi = lane >> 5;
  bf16_t* V_lds = (bf16_t*)lds; bf16_t* K_lds = (bf16_t*)(lds + 2 * SHM_V);
  float* ws = (float*)(lds + 2 * SHM_V + 2 * SHM_K) + wid * 64; float* li_l = ws; float* al_l = ws + 32;
  float m_reg = -1e30f, l_reg = 0; f32x16 o[4] = {}; bf16x8 qr[8];
  const bf16_t* Qw = Qb + (long)(wid * QBLK + r32) * LDQ + hi * 8;
#pragma unroll
  for (int d0 = 0; d0 < 8; ++d0) qr[d0] = *reinterpret_cast<const bf16x8*>(Qw + d0 * 16);
  const int sr = tid >> 4, sc = (tid & 15) * 8, vst0 = v_st(sr, sc), vst1 = v_st(32 + sr, sc);
  const int vb0 = (int)(uintptr_t)V_lds + v_rd_base(lane);
  struct { bf16x8 vs0, vs1, ks0, ks1; } sr_[2];
#define SLOAD(i, k0) do { sr_[i].vs0 = *reinterpret_cast<const bf16x8*>(&Vh[(long)((k0) + sr) * LDK + sc]); sr_[i].vs1 = *reinterpret_cast<const bf16x8*>(&Vh[(long)((k0) + 32 + sr) * LDK + sc]); \
    sr_[i].ks0 = *reinterpret_cast<const bf16x8*>(&Kh[(long)((k0) + sr) * LDK + sc]); sr_[i].ks1 = *reinterpret_cast<const bf16x8*>(&Kh[(long)((k0) + 32 + sr) * LDK + sc]); } while (0)
#define SWRITE(b, i) do { *(bf16x8*)((char*)V_lds + (b) * SHM_V + vst0) = sr_[i].vs0;          \
    *(bf16x8*)((char*)V_lds + (b) * SHM_V + vst1) = sr_[i].vs1; int kc = sc * 2;               \
    *(bf16x8*)((char*)K_lds + (b) * SHM_K + KSWZ(sr, kc)) = sr_[i].ks0;                       \
    *(bf16x8*)((char*)K_lds + (b) * SHM_K + KSWZ(32 + sr, kc)) = sr_[i].ks1; } while (0)
#define SWAIT() asm volatile("s_waitcnt vmcnt(4)" ::: "memory")
#define RESC(a) do { if (__any((a) < 1.f)) { if (hi == 0) al_l[r32] = (a); asm volatile("s_waitcnt lgkmcnt(0)" ::: "memory"); \
    for (int d = 0; d < 4; ++d) for (int r = 0; r < 16; ++r) o[d][r] *= al_l[crow(r, hi)]; } } while (0)
  f32x16 pA0, pA1, pB0, pB1; float mnA, mnB, alA, alB; bf16x8 pa0, pa1, pa2, pa3; const int NT = seq / KVBLK;
  constexpr int SE = 0, SO = 1;
  SLOAD(SE, 0); asm volatile("s_waitcnt vmcnt(0)" ::: "memory"); SWRITE(0, SE); __syncthreads();
  qkt(pA0, pA1, K_lds, qr, r32, hi); partialSM(pA0, pA1, m_reg, mnA, alA);
  SLOAD(SO, KVBLK); if (2 < NT) SLOAD(SE, 2 * KVBLK);
  SWAIT(); SWRITE(1, SO); __syncthreads();
  for (int j = 1; j + 1 < NT; j += 2) {
    SBAR(); qkt(pB0, pB1, (bf16_t*)((char*)K_lds + SHM_K), qr, r32, hi);
    finishSM(pA0, pA1, alA, l_reg, pa0, pa1, pa2, pa3); SBAR();
    SLOAD(SO, (j + 2) * KVBLK); SBAR();
    pv_d0(o, vb0, pa0, pa1, pa2, pa3); partialSM(pB0, pB1, m_reg, mnB, alB);
    __syncthreads(); SWAIT(); SWRITE(0, SE);
    RESC(alB); __syncthreads();
    SBAR(); qkt(pA0, pA1, K_lds, qr, r32, hi);
    finishSM(pB0, pB1, alB, l_reg, pa0, pa1, pa2, pa3); SBAR();
    if (j + 3 < NT) SLOAD(SE, (j + 3) * KVBLK); SBAR();
    pv_d0(o, vb0 + (int)SHM_V, pa0, pa1, pa2, pa3); partialSM(pA0, pA1, m_reg, mnA, alA);
    __syncthreads(); SWAIT(); SWRITE(1, SO);
    RESC(alA); __syncthreads();
  }
  SBAR(); qkt(pB0, pB1, (bf16_t*)((char*)K_lds + SHM_K), qr, r32, hi);
  finishSM(pA0, pA1, alA, l_reg, pa0, pa1, pa2, pa3); SBAR();
  pv_d0(o, vb0, pa0, pa1, pa2, pa3); partialSM(pB0, pB1, m_reg, mnB, alB);
  __syncthreads(); RESC(alB);
  finishSM(pB0, pB1, alB, l_reg, pa0, pa1, pa2, pa3); SBAR();
  pv_d0(o, vb0 + (int)SHM_V, pa0, pa1, pa2, pa3);
  if (hi == 0) li_l[r32] = l_reg; asm volatile("s_waitcnt lgkmcnt(0)" ::: "memory");
  float rli[16];
#pragma unroll
  for (int r = 0; r < 16; ++r) rli[r] = __builtin_amdgcn_rcpf(li_l[crow(r, hi)]);
  bf16_t* Ow = Ob + (long)(wid * QBLK) * LDO;
#pragma unroll
  for (int r = 0; r < 16; ++r) { int orow = crow(r, hi);
    for (int d0 = 0; d0 < 4; ++d0) Ow[(long)orow * LDO + d0 * 32 + r32] = f2bf_s(o[d0][r] * rli[r]); }
#undef SLOAD
#undef SWRITE
#undef SWAIT
#undef RESC
}
}

namespace win {
constexpr int D = 64, BAND = 320, NTILE = 5;
constexpr int LDS_K = 0, LDS_V = BAND * D * 2, LDS_WS = 2 * BAND * D * 2, LDS_Q = LDS_WS + NW * 64 * 4, LDS_BYTES = LDS_Q + 16;
#define KSWZ64(row, colB) ((row) * 128 + ((colB) ^ ((((row) >> 1) & 7) << 4)))
__device__ __forceinline__ int v_st64(int k, int c) { const int kk = (k & ~0xC) | ((k & 4) << 1) | ((k & 8) >> 1); return ((kk >> 3) * 2 + (c >> 5)) * 512 + ((kk & 7) * 32 + (c & 31)) * 2; }
constexpr int v_rd_off64(int d0, int ks, int half) { return d0 * 512 + ks * 2048 + half * 1024; }
template <int D0> __device__ __forceinline__ void pv_one64(f32x16& od, int vb, bf16x8 pa0, bf16x8 pa1, bf16x8 pa2, bf16x8 pa3) {
  const s16x4 l0 = tr_read<v_rd_off64(D0, 0, 0)>(vb), h0 = tr_read<v_rd_off64(D0, 0, 1)>(vb), l1 = tr_read<v_rd_off64(D0, 1, 0)>(vb), h1 = tr_read<v_rd_off64(D0, 1, 1)>(vb);
  const s16x4 l2 = tr_read<v_rd_off64(D0, 2, 0)>(vb), h2 = tr_read<v_rd_off64(D0, 2, 1)>(vb), l3 = tr_read<v_rd_off64(D0, 3, 0)>(vb), h3 = tr_read<v_rd_off64(D0, 3, 1)>(vb);
  asm volatile("s_waitcnt lgkmcnt(0)" ::: "memory"); SBAR();
  od = __builtin_amdgcn_mfma_f32_32x32x16_bf16(pa0, PKF(l0, h0), od, 0, 0, 0);
  od = __builtin_amdgcn_mfma_f32_32x32x16_bf16(pa1, PKF(l1, h1), od, 0, 0, 0);
  od = __builtin_amdgcn_mfma_f32_32x32x16_bf16(pa2, PKF(l2, h2), od, 0, 0, 0);
  od = __builtin_amdgcn_mfma_f32_32x32x16_bf16(pa3, PKF(l3, h3), od, 0, 0, 0);
}
__device__ __forceinline__ void tile(const bool MASKED, int jt, const char* K_lds, int vb0, const bf16x8 (&qr)[4], f32x16 (&o)[2], float& m_reg, float& l_reg, float* al_l,
                                     int q0, int qp, float dq, float slope2, int r32, int hi) {
  constexpr int SEQ = 4096;
  constexpr float C1 = 0.125f * 1.4426950408889634f;
  SBAR();
  f32x16 p0 = f32x16{}, p1 = f32x16{};
  const char* Kt = K_lds + jt * 8192;
#pragma unroll
  for (int d0 = 0; d0 < 4; ++d0) { const int cb = (d0 * 16 + hi * 8) * 2;
    bf16x8 b0 = *reinterpret_cast<const bf16x8*>(Kt + KSWZ64(r32, cb));
    bf16x8 b1 = *reinterpret_cast<const bf16x8*>(Kt + KSWZ64(32 + r32, cb));
    p0 = __builtin_amdgcn_mfma_f32_32x32x16_bf16(b0, qr[d0], p0, 0, 0, 0);
    p1 = __builtin_amdgcn_mfma_f32_32x32x16_bf16(b1, qr[d0], p1, 0, 0, 0); }
  const float dt = dq - 64.0f * (float)jt;
  float pmax = -1e30f;
  if (MASKED) {
    const int kbase = q0 - 128 + jt * 64;
#pragma unroll
    for (int r = 0; r < 16; ++r) {
      const int k0 = kbase + crow(r, hi), k1 = k0 + 32;
      const float d0f = fabsf(dt - (float)((r & 3) + 8 * (r >> 2))), d1f = fabsf(dt - (float)((r & 3) + 8 * (r >> 2) + 32));
      const bool v0 = (d0f <= 128.0f) && (k0 >= 0) && (k0 < SEQ), v1 = (d1f <= 128.0f) && (k1 >= 0) && (k1 < SEQ);
      p0[r] = v0 ? fmaf(p0[r], C1, -slope2 * d0f) : -1e30f;
      p1[r] = v1 ? fmaf(p1[r], C1, -slope2 * d1f) : -1e30f;
      pmax = fmaxf(pmax, fmaxf(p0[r], p1[r]));
    }
  } else {
#pragma unroll
    for (int r = 0; r < 16; ++r) {
      const float d0f = fabsf(dt - (float)((r & 3) + 8 * (r >> 2))), d1f = fabsf(dt - (float)((r & 3) + 8 * (r >> 2) + 32));
      p0[r] = fmaf(p0[r], C1, -slope2 * d0f);
      p1[r] = fmaf(p1[r], C1, -slope2 * d1f);
      pmax = fmaxf(pmax, fmaxf(p0[r], p1[r]));
    }
  }
  { auto rr = __builtin_amdgcn_permlane32_swap(__float_as_uint(pmax), __float_as_uint(pmax), false, false);
    pmax = fmaxf(__uint_as_float(rr[0]), __uint_as_float(rr[1])); }
  const float mn = fmaxf(m_reg, pmax), alpha = __builtin_amdgcn_exp2f(m_reg - mn); m_reg = mn;
  float ps = 0.f;
#pragma unroll
  for (int r = 0; r < 16; ++r) { p0[r] = __builtin_amdgcn_exp2f(p0[r] - mn); p1[r] = __builtin_amdgcn_exp2f(p1[r] - mn); ps += p0[r] + p1[r]; }
  { auto rr = __builtin_amdgcn_permlane32_swap(__float_as_uint(ps), __float_as_uint(ps), false, false);
    ps = __uint_as_float(rr[0]) + __uint_as_float(rr[1]); }
  l_reg = l_reg * alpha + ps;
  if (__any(alpha < 1.f)) { if (hi == 0) al_l[r32] = alpha; asm volatile("s_waitcnt lgkmcnt(0)" ::: "memory");
#pragma unroll
    for (int r = 0; r < 16; ++r) { const float a = al_l[crow(r, hi)]; o[0][r] *= a; o[1][r] *= a; } }
  bf16x8 pa0, pa1, pa2, pa3;
  PK4(p0, 0, pa0); PK4(p0, 8, pa1); PK4(p1, 0, pa2); PK4(p1, 8, pa3);
  const int vb = vb0 + jt * 8192;
  pv_one64<0>(o[0], vb, pa0, pa1, pa2, pa3); pv_one64<1>(o[1], vb, pa0, pa1, pa2, pa3);
  SBAR();
}
struct Band { bf16x8 k[5], v[5]; };
__device__ __forceinline__ void band_load(Band& B, const bf16_t* __restrict__ KVA, int b, int kvh, int q0, int tid) {
  constexpr int SEQ = 4096;
#pragma unroll
  for (int j = 0; j < 5; ++j) { const int c = tid + 512 * j, key = c >> 3, ch = c & 7; int kp = q0 - 128 + key; kp = kp < 0 ? 0 : (kp > SEQ - 1 ? SEQ - 1 : kp);
    const bf16_t* src = KVA + ((long)b * SEQ + kp) * 256 + kvh * 64 + ch * 8;
    B.k[j] = *reinterpret_cast<const bf16x8*>(src); B.v[j] = *reinterpret_cast<const bf16x8*>(src + 128); }
}
__device__ __forceinline__ void band_store(const Band& B, char* K_lds, char* V_lds, int tid) {
#pragma unroll
  for (int j = 0; j < 5; ++j) { const int c = tid + 512 * j, key = c >> 3, ch = c & 7;
    *(bf16x8*)(K_lds + KSWZ64(key, ch * 16)) = B.k[j];
    *(bf16x8*)(V_lds + (key >> 6) * 8192 + v_st64(key & 63, ch * 8)) = B.v[j]; }
}
__device__ __forceinline__ void run(const bf16_t* __restrict__ QA, const bf16_t* __restrict__ KVA, bf16_t* __restrict__ OAB, const float* __restrict__ sinks, int first, int G, int nunits, unsigned* queue, char* lds) {
  constexpr int SEQ = 4096;
  constexpr float LOG2E = 1.4426950408889634f;
  int tid_ = threadIdx.x; asm volatile("" : "+v"(tid_));
  const int tid = tid_, wid = tid >> 6, lane = tid & 63, r32 = lane & 31, hi = lane >> 5;
  char* K_lds = lds + LDS_K; char* V_lds = lds + LDS_V;
  float* ws = (float*)(lds + LDS_WS) + wid * 64; float* li_l = ws; float* al_l = ws + 32;
  volatile int* qslot = (volatile int*)(lds + LDS_Q);
  const int vb0 = (int)(uintptr_t)V_lds + v_rd_base(lane);
  int u = first; if (u >= nunits) return;
  if (tid == 0) qslot[0] = G + (int)__hip_atomic_fetch_add(queue, 1u, __ATOMIC_RELAXED, __HIP_MEMORY_SCOPE_AGENT);
  Band B; band_load(B, KVA, u >> 7, (u >> 6) & 1, (u & 63) * 64, tid);
  __syncthreads();
  int un = qslot[0];
  for (;;) {
    const int q0 = (u & 63) * 64, kvh = (u >> 6) & 1, b = u >> 7;
    const long rowbase = (long)b * SEQ;
    band_store(B, K_lds, V_lds, tid);
    if (un < nunits) band_load(B, KVA, un >> 7, (un >> 6) & 1, (un & 63) * 64, tid);
    const int g = wid & 3, rb = wid >> 2, h = kvh * 4 + g;
    const int qrow0 = q0 + 32 * rb;
    bf16x8 qr[4];
    { const bf16_t* Qw = QA + (rowbase + qrow0 + r32) * 512 + h * 64 + hi * 8;
#pragma unroll
      for (int d0 = 0; d0 < 4; ++d0) qr[d0] = *reinterpret_cast<const bf16x8*>(Qw + d0 * 16); }
    const float slope2 = __builtin_amdgcn_exp2f(-(float)(h + 1)) * LOG2E;
    float m_reg = sinks[h] * LOG2E, l_reg = 1.0f;
    f32x16 o[2] = {};
    const int qp = qrow0 + r32;
    const float dq = (float)(qp - (q0 - 128) - 4 * hi);
    __syncthreads();
    if (tid == 0 && un < nunits) qslot[0] = G + (int)__hip_atomic_fetch_add(queue, 1u, __ATOMIC_RELAXED, __HIP_MEMORY_SCOPE_AGENT);
    const bool edge = (q0 < 128) || (q0 + 192 > SEQ);
#pragma unroll 1
    for (int i = 0; i < NTILE; ++i) { const int jt = 2 + ((i & 1) ? -((i + 1) >> 1) : ((i + 1) >> 1));
      tile(edge || i >= 3, jt, K_lds, vb0, qr, o, m_reg, l_reg, al_l, q0, qp, dq, slope2, r32, hi); }
    if (hi == 0) li_l[r32] = l_reg; asm volatile("s_waitcnt lgkmcnt(0)" ::: "memory");
    bf16_t* Ow = OAB + (rowbase + qrow0) * 1024 + h * 64;
#pragma unroll
    for (int r = 0; r < 16; ++r) { const int orow = crow(r, hi); const float rl = __builtin_amdgcn_rcpf(li_l[orow]);
#pragma unroll
      for (int d0 = 0; d0 < 2; ++d0) Ow[(long)orow * 1024 + d0 * 32 + r32] = f2bf_s(o[d0][r] * rl); }
    __syncthreads();
    if (un >= nunits) break;
    u = un; un = qslot[0];
  }
}
}
#undef KSWZ
#undef KSWZ64
#undef SBAR
#undef PK4
#undef PKF
}
constexpr int NWAVES = 8;
constexpr int BATCH = 8, SEQ = 4096, DM = 1024, M = BATCH * SEQ;
constexpr int NIN = 3840, DFF = 2816, NGV = 2 * DFF;
constexpr float LN_EPS = 1e-5f, RMS_EPS = 1e-6f;
constexpr float ALPHA = 1.189207115002721f;

constexpr size_t MiB = 1u << 20;
constexpr size_t WS_CTL = 0, CTL_ZERO_BYTES = 1 * MiB;
constexpr size_t WS_WIN = 2 * MiB;
constexpr size_t WS_WOAB = 10 * MiB;
constexpr size_t WS_WOUT = 12 * MiB;
constexpr size_t WS_WGV = 14 * MiB;
constexpr size_t WS_WD = 25 * MiB;
constexpr size_t WS_PB = 31 * MiB, WS_GB = 34 * MiB, WS_VBND = 37 * MiB;
constexpr size_t WS_STAT0 = 40 * MiB, WS_STAT1 = 41 * MiB;
constexpr size_t WS_RS1 = 43 * MiB, WS_RS2 = 44 * MiB;
constexpr size_t WS_C1 = 45 * MiB, WS_C2 = 45 * MiB + 65536;
constexpr size_t WS_ROPE = 42 * MiB;
constexpr size_t WS_H0B = 48 * MiB;
constexpr size_t WS_QA = 112 * MiB;
constexpr size_t WS_KVA = 144 * MiB;
constexpr size_t WS_QB = 160 * MiB;
constexpr size_t WS_KB = 192 * MiB;
constexpr size_t WS_VB = 208 * MiB;
constexpr size_t WS_GATES = 224 * MiB;
constexpr size_t WS_OAB = 352 * MiB;
constexpr size_t WS_MERGED = 416 * MiB;
constexpr size_t WS_ACT = 112 * MiB;
constexpr size_t WS_END = 480 * MiB;
static_assert(WS_ACT + (size_t)M * DFF * 2 <= WS_OAB, "act overlay");

constexpr int CW_BAR = 4096;
constexpr int CW_WINQ = 128;
constexpr int CW_ERR = 64;
constexpr int RING_BYTES = 131072, XLDS_OFF = RING_BYTES, MISC_OFF = RING_BYTES + 8192, LDS_BYTES = 147456;

#define GAS __attribute__((address_space(1)))
#define LAS __attribute__((address_space(3)))
typedef unsigned short bf16;
typedef unsigned v4u __attribute__((ext_vector_type(4)));
typedef float f32x4 __attribute__((ext_vector_type(4)));
typedef float f32x2 __attribute__((ext_vector_type(2)));
__device__ __forceinline__ unsigned f2bf(float f) { unsigned u = __builtin_bit_cast(unsigned, f); return (u + 0x7fffu + ((u >> 16) & 1u)) >> 16; }
__device__ __forceinline__ unsigned pk2(float lo, float hi) { return f2bf(lo) | (f2bf(hi) << 16); }
__device__ __forceinline__ float bf2f(unsigned short v) { return __uint_as_float((unsigned)v << 16); }

struct Args { const float* in[20]; float* out; unsigned char* ws; };
struct Frame { LAS unsigned char* lds; int tid, lane, wave, vcu, G; };
struct Ptrs {
    const float *x, *ln_in_g, *ln_in_b, *w_in, *b_in, *a_sinks, *bq_norm, *bk_norm, *w_oa, *w_ob, *w_out, *ln1_g, *ln1_b, *w_gate, *w_val, *conv_w, *conv_b, *w_down, *ln2_g, *ln2_b;
    float* out; unsigned* ctl;
    bf16 *WinT, *WoabT, *WoutT, *WgvT, *WdT, *H0B, *QA, *KVA, *QB, *KB, *VB, *GATES, *OAB, *MERGED, *ACT;
    float *Pb, *Gb, *Vbnd, *ROPE, *C1, *C2; f32x2 *STAT0, *STAT1; long long *RS1, *RS2;
};
__device__ __forceinline__ Ptrs get_ptrs() {
    const __attribute__((address_space(4))) Args* a = (const __attribute__((address_space(4))) Args*)__builtin_amdgcn_kernarg_segment_ptr(); asm volatile("" : "+s"(a));
    Ptrs P; unsigned char* ws = a->ws;
    P.x = a->in[0]; P.ln_in_g = a->in[1]; P.ln_in_b = a->in[2]; P.w_in = a->in[3]; P.b_in = a->in[4]; P.a_sinks = a->in[5]; P.bq_norm = a->in[6]; P.bk_norm = a->in[7];
    P.w_oa = a->in[8]; P.w_ob = a->in[9]; P.w_out = a->in[10]; P.ln1_g = a->in[11]; P.ln1_b = a->in[12]; P.w_gate = a->in[13]; P.w_val = a->in[14];
    P.conv_w = a->in[15]; P.conv_b = a->in[16]; P.w_down = a->in[17]; P.ln2_g = a->in[18]; P.ln2_b = a->in[19]; P.out = a->out;
    P.ctl = (unsigned*)(ws + WS_CTL);
    P.WinT = (bf16*)(ws + WS_WIN); P.WoabT = (bf16*)(ws + WS_WOAB); P.WoutT = (bf16*)(ws + WS_WOUT); P.WgvT = (bf16*)(ws + WS_WGV); P.WdT = (bf16*)(ws + WS_WD);
    P.H0B = (bf16*)(ws + WS_H0B); P.QA = (bf16*)(ws + WS_QA); P.KVA = (bf16*)(ws + WS_KVA); P.QB = (bf16*)(ws + WS_QB); P.KB = (bf16*)(ws + WS_KB); P.VB = (bf16*)(ws + WS_VB);
    P.GATES = (bf16*)(ws + WS_GATES); P.OAB = (bf16*)(ws + WS_OAB); P.MERGED = (bf16*)(ws + WS_MERGED); P.ACT = (bf16*)(ws + WS_ACT);
    P.Pb = (float*)(ws + WS_PB); P.Gb = (float*)(ws + WS_GB); P.Vbnd = (float*)(ws + WS_VBND); P.ROPE = (float*)(ws + WS_ROPE);
    P.STAT0 = (f32x2*)(ws + WS_STAT0); P.STAT1 = (f32x2*)(ws + WS_STAT1);
    P.C1 = (float*)(ws + WS_C1); P.C2 = (float*)(ws + WS_C2); P.RS1 = (long long*)(ws + WS_RS1); P.RS2 = (long long*)(ws + WS_RS2);
    return P;
}

__device__ __forceinline__ float wave_sum(float v) {
#pragma unroll
    for (int o = 1; o < 64; o <<= 1) v += __shfl_xor(v, o);
    return v;
}
__device__ __forceinline__ void p0_transpose_item(const float* W, int N, bf16* WT, int ldk, int koff, int drow0, int k0, int n0, LAS float* scr, int lane, bool perm = false) {
    float wv[32];
#pragma unroll
    for (int i = 0; i < 32; ++i) wv[i] = W[(size_t)(k0 + 2 * i + (lane >> 5)) * N + n0 + (lane & 31)];
#pragma unroll
    for (int i = 0; i < 32; ++i) scr[(2 * i + (lane >> 5)) * 33 + (lane & 31)] = wv[i];
    asm volatile("s_waitcnt lgkmcnt(0)" ::: "memory");
    const int c = lane & 7;
#pragma unroll
    for (int j = 0; j < 4; ++j) { const int n = (lane >> 3) + 8 * j; const LAS float* s = scr + (8 * c) * 33 + n;
        v4u o; o.x = pk2(s[0 * 33], s[1 * 33]); o.y = pk2(s[2 * 33], s[3 * 33]); o.z = pk2(s[4 * 33], s[5 * 33]); o.w = pk2(s[6 * 33], s[7 * 33]);
        *(GAS v4u*)(WT + (size_t)(drow0 + (perm ? 8 * (n >> 2) + (n & 3) : n)) * ldk + koff + k0 + 8 * c) = o; }
    asm volatile("s_waitcnt lgkmcnt(0)" ::: "memory");
}
template <bool TO_BF16, bool TO_F32>
__device__ __forceinline__ void ln_row(const float* xrow, const float* g, const float* b, bf16* orow, float* frow, f32x2* stat, int lane) {
    const GAS f32x4* xr = (const GAS f32x4*)xrow + lane;
    f32x4 v[4]; float s = 0.f;
#pragma unroll
    for (int j = 0; j < 4; ++j) { v[j] = xr[64 * j]; s += (v[j].x + v[j].y) + (v[j].z + v[j].w); }
    const float mean = wave_sum(s) * (1.f / DM); float s2 = 0.f;
#pragma unroll
    for (int j = 0; j < 4; ++j) { v[j] = v[j] - mean; s2 += (v[j].x * v[j].x + v[j].y * v[j].y) + (v[j].z * v[j].z + v[j].w * v[j].w); }
    const float rstd = 1.f / sqrtf(wave_sum(s2) * (1.f / DM) + LN_EPS);
    if (stat && lane == 0) *stat = (f32x2){mean, rstd};
#pragma unroll
    for (int j = 0; j < 4; ++j) { const f32x4 gg = ((const GAS f32x4*)g)[lane + 64 * j], bb = ((const GAS f32x4*)b)[lane + 64 * j]; const f32x4 y = v[j] * rstd * gg + bb;
        if (TO_BF16) ((GAS unsigned long long*)orow)[lane + 64 * j] = (unsigned long long)pk2(y.x, y.y) | ((unsigned long long)pk2(y.z, y.w) << 32);
        if (TO_F32) ((GAS f32x4*)frow)[lane + 64 * j] = y; }
}

__device__ __forceinline__ void ln_apply_row(const float* zrow, const long long* RS, int m, const float* g, const float* b, float* orow, int lane) {
    float mean, rstd; pg8::fx_stats(RS, (unsigned)m, LN_EPS, mean, rstd);
#pragma unroll
    for (int j = 0; j < 4; ++j) { const f32x4 v = ((const GAS f32x4*)zrow)[lane + 64 * j], gg = ((const GAS f32x4*)g)[lane + 64 * j], bb = ((const GAS f32x4*)b)[lane + 64 * j];
        ((GAS f32x4*)orow)[lane + 64 * j] = (v - mean) * rstd * gg + bb; }
}

__device__ __forceinline__ void p0_prologue(Frame& F) {
    const Ptrs P = get_ptrs();
    LAS float* scr = (LAS float*)(F.lds + F.wave * 16384);
    const int gw = F.vcu * NWAVES + F.wave, NGW = F.G * NWAVES;
    constexpr int I_IN = (DM / 64) * (NIN / 32), I_OA = (512 / 64) * (DM / 32), I_OUT = (DM / 64) * (DM / 32), I_G = (DM / 64) * (DFF / 32), I_D = (DFF / 64) * (DM / 32);
    constexpr int NITEMS = I_IN + 2 * I_OA + I_OUT + 2 * I_G + I_D;
    for (int it = gw; it < NITEMS; it += NGW) {
        int r = it;
        if (r < I_IN) { const int nb = NIN / 32, kb = r / nb, n0 = 32 * (r % nb);
            const bool pm = (n0 >= 768 && n0 < 1536); const int q = (n0 & 127) >> 5;
            p0_transpose_item(P.w_in, NIN, P.WinT, DM, 0, pm ? (n0 & ~127) + (q >> 1) * 64 + (q & 1) * 4 : n0, 64 * kb, n0, scr, F.lane, pm); continue; } r -= I_IN;
        if (r < I_OA) { const int nb = DM / 32, kb = r / nb, n0 = 32 * (r % nb); p0_transpose_item(P.w_oa, DM, P.WoabT, DM, 0, n0, 64 * kb, n0, scr, F.lane); continue; } r -= I_OA;
        if (r < I_OA) { const int nb = DM / 32, kb = r / nb, n0 = 32 * (r % nb); p0_transpose_item(P.w_ob, DM, P.WoabT, DM, 512, n0, 64 * kb, n0, scr, F.lane); continue; } r -= I_OA;
        if (r < I_OUT) { const int nb = DM / 32, kb = r / nb, n0 = 32 * (r % nb); p0_transpose_item(P.w_out, DM, P.WoutT, DM, 0, n0, 64 * kb, n0, scr, F.lane); continue; } r -= I_OUT;
        if (r < I_G) { const int nb = DFF / 32, kb = r / nb, n0 = 32 * (r % nb); p0_transpose_item(P.w_gate, DFF, P.WgvT, DM, 0, 256 * (n0 / 128) + (n0 % 128), 64 * kb, n0, scr, F.lane); continue; } r -= I_G;
        if (r < I_G) { const int nb = DFF / 32, kb = r / nb, n0 = 32 * (r % nb); p0_transpose_item(P.w_val, DFF, P.WgvT, DM, 0, 256 * (n0 / 128) + 128 + (n0 % 128), 64 * kb, n0, scr, F.lane); continue; } r -= I_G;
        { const int nb = DM / 32, kb = r / nb, n0 = 32 * (r % nb); p0_transpose_item(P.w_down, DM, P.WdT, DFF, 0, n0, 64 * kb, n0, scr, F.lane); }
    }
    { const int gt = (F.vcu * NWAVES + F.wave) * 64 + F.lane;
      if (gt < 64 * 32) { const int pos = gt >> 5, k = gt & 31; const float freq = powf(10000.0f, -(float)k / 32.0f), ang = (float)pos * freq;
          P.ROPE[2 * gt] = cosf(ang); P.ROPE[2 * gt + 1] = sinf(ang); } }
    for (int m = gw; m < M; m += 2 * NGW) {
        const int m2 = m + NGW; const bool has2 = m2 < M; const int mb = has2 ? m2 : m;
        const GAS f32x4* xa = (const GAS f32x4*)(P.x + (size_t)m * DM) + F.lane; const GAS f32x4* xb = (const GAS f32x4*)(P.x + (size_t)mb * DM) + F.lane;
        f32x4 va[4], vb[4]; float sa = 0.f, sb = 0.f;
#pragma unroll
        for (int j = 0; j < 4; ++j) { va[j] = xa[64 * j]; vb[j] = xb[64 * j]; }
#pragma unroll
        for (int j = 0; j < 4; ++j) { sa += (va[j].x + va[j].y) + (va[j].z + va[j].w); sb += (vb[j].x + vb[j].y) + (vb[j].z + vb[j].w); }
#pragma unroll
        for (int o = 1; o < 64; o <<= 1) { sa += __shfl_xor(sa, o); sb += __shfl_xor(sb, o); }
        const float ma = sa * (1.f / DM), mbn = sb * (1.f / DM); float qa = 0.f, qb = 0.f;
#pragma unroll
        for (int j = 0; j < 4; ++j) { va[j] = va[j] - ma; vb[j] = vb[j] - mbn; qa += (va[j].x * va[j].x + va[j].y * va[j].y) + (va[j].z * va[j].z + va[j].w * va[j].w); qb += (vb[j].x * vb[j].x + vb[j].y * vb[j].y) + (vb[j].z * vb[j].z + vb[j].w * vb[j].w); }
#pragma unroll
        for (int o = 1; o < 64; o <<= 1) { qa += __shfl_xor(qa, o); qb += __shfl_xor(qb, o); }
        const float ra = 1.f / sqrtf(qa * (1.f / DM) + LN_EPS), rb = 1.f / sqrtf(qb * (1.f / DM) + LN_EPS);
        if (F.lane == 0) { P.STAT0[m] = (f32x2){ma, ra}; if (has2) P.STAT0[m2] = (f32x2){mbn, rb}; }
        if (F.lane < 2) { P.RS1[2 * (size_t)m + F.lane] = 0; P.RS2[2 * (size_t)m + F.lane] = 0; if (has2) { P.RS1[2 * (size_t)m2 + F.lane] = 0; P.RS2[2 * (size_t)m2 + F.lane] = 0; } }
#pragma unroll
        for (int j = 0; j < 4; ++j) { const f32x4 gg = ((const GAS f32x4*)P.ln_in_g)[F.lane + 64 * j], bb = ((const GAS f32x4*)P.ln_in_b)[F.lane + 64 * j];
            const f32x4 ya = va[j] * ra * gg + bb, yb = vb[j] * rb * gg + bb;
            ((GAS unsigned long long*)(P.H0B + (size_t)m * DM))[F.lane + 64 * j] = (unsigned long long)pk2(ya.x, ya.y) | ((unsigned long long)pk2(ya.z, ya.w) << 32);
            if (has2) ((GAS unsigned long long*)(P.H0B + (size_t)m2 * DM))[F.lane + 64 * j] = (unsigned long long)pk2(yb.x, yb.y) | ((unsigned long long)pk2(yb.z, yb.w) << 32); }
    }
}

__device__ __forceinline__ void p1b_norm_rope(Frame& F) {
    const Ptrs P = get_ptrs();
    const int gw = F.vcu * NWAVES + F.wave, NGW = F.G * NWAVES;
    const int j = F.lane & 15, sub = F.lane >> 4;
    for (int it = gw; it < M + M / 2; it += NGW) {
        const bool isq = it < M; const int hv = (isq ? it : it - M) * 4 + sub;
        bf16* p = (isq ? P.QB : P.KB) + (size_t)hv * 128 + 8 * j;
        const int t = isq ? (hv >> 2) : (hv >> 1), ts = t & (SEQ - 1), pos = (j & 8) ? (ts & 63) : (ts >> 6);
        const float* sc = (isq ? P.bq_norm : P.bk_norm) + 8 * j;
        const v4u w = *(const GAS v4u*)p;
        float v[8] = {__uint_as_float(w.x << 16), __uint_as_float(w.x & 0xffff0000u), __uint_as_float(w.y << 16), __uint_as_float(w.y & 0xffff0000u),
                      __uint_as_float(w.z << 16), __uint_as_float(w.z & 0xffff0000u), __uint_as_float(w.w << 16), __uint_as_float(w.w & 0xffff0000u)};
        float ss = 0.f;
#pragma unroll
        for (int e = 0; e < 8; ++e) ss += v[e] * v[e];
        ss += __shfl_xor(ss, 1); ss += __shfl_xor(ss, 2); ss += __shfl_xor(ss, 4); ss += __shfl_xor(ss, 8);
        const float rstd = 1.0f / sqrtf(ss * (1.0f / 128.0f) + RMS_EPS);
        const f32x4 s0 = *(const GAS f32x4*)sc, s1 = *(const GAS f32x4*)(sc + 4);
        const float scv[8] = {s0.x, s0.y, s0.z, s0.w, s1.x, s1.y, s1.z, s1.w};
        const float* tab = P.ROPE + ((size_t)pos * 32 + 8 * (j & 3)) * 2;
        float o[8];
#pragma unroll
        for (int e = 0; e < 8; ++e) { const float y = v[e] * rstd * scv[e]; const float py = __shfl_xor(y, 4);
            const float cs = tab[2 * e], sn = tab[2 * e + 1];
            o[e] = (j & 4) ? (py * sn + y * cs) : (y * cs - py * sn); }
        v4u ow; ow.x = pk2(o[0], o[1]); ow.y = pk2(o[2], o[3]); ow.z = pk2(o[4], o[5]); ow.w = pk2(o[6], o[7]);
        *(GAS v4u*)p = ow;
    }
}

__device__ __forceinline__ void p1c_fold_vectors(Frame& F) {
    const Ptrs P = get_ptrs();
    const int gw = F.vcu * NWAVES + F.wave, NGW = F.G * NWAVES;
    for (int n = gw; n < NGV; n += NGW) {
        float s1 = 0.f, s2 = 0.f;
#pragma unroll
        for (int i = 0; i < 2; ++i) { const int k = (F.lane + 64 * i) * 8; const v4u w = *(const GAS v4u*)(P.WgvT + (size_t)n * DM + k);
            const f32x4 ga = *(const GAS f32x4*)(P.ln1_g + k), gb = *(const GAS f32x4*)(P.ln1_g + k + 4), ba = *(const GAS f32x4*)(P.ln1_b + k), bb = *(const GAS f32x4*)(P.ln1_b + k + 4);
            const float wv[8] = {__uint_as_float(w.x << 16), __uint_as_float(w.x & 0xffff0000u), __uint_as_float(w.y << 16), __uint_as_float(w.y & 0xffff0000u),
                                 __uint_as_float(w.z << 16), __uint_as_float(w.z & 0xffff0000u), __uint_as_float(w.w << 16), __uint_as_float(w.w & 0xffff0000u)};
            s1 += wv[0] * ga.x + wv[1] * ga.y + wv[2] * ga.z + wv[3] * ga.w + wv[4] * gb.x + wv[5] * gb.y + wv[6] * gb.z + wv[7] * gb.w;
            s2 += wv[0] * ba.x + wv[1] * ba.y + wv[2] * ba.z + wv[3] * ba.w + wv[4] * bb.x + wv[5] * bb.y + wv[6] * bb.z + wv[7] * bb.w; }
        s1 = wave_sum(s1); s2 = wave_sum(s2);
        if (F.lane == 0) { P.C1[n] = s1; P.C2[n] = s2; }
    }
}

__device__ __forceinline__ void p5b_fixup(Frame& F) {
    const Ptrs P = get_ptrs();
    const int gt = (F.vcu * NWAVES + F.wave) * 64 + F.lane, NGT = F.G * NWAVES * 64;
    constexpr int NT = M / 256;
    for (int i = gt; i < NT * 2 * DFF; i += NGT) {
        const int c = i % DFF, ts = i / DFF, side = ts & 1, pm = ts >> 1;
        float ext = 0.f; int row;
        if (side == 0) { row = 256 * pm; if ((pm & 15) != 0) ext = P.Gb[((size_t)(pm - 1) * 2 + 1) * DFF + c]; ext *= P.conv_w[c]; }
        else { row = 256 * pm + 255; if ((pm & 15) != 15) ext = P.Gb[((size_t)(pm + 1) * 2 + 0) * DFF + c]; ext *= P.conv_w[2 * DFF + c]; }
        const float cv = P.Pb[(size_t)i] + ext;
        const pg8::f32x2 ge = pg8::gelu_pk((pg8::f32x2){cv, 0.f});
        P.ACT[(size_t)row * DFF + c] = (bf16)f2bf(ge.x * P.Vbnd[(size_t)i]);
    }
}
#ifndef PHM
#define PHM 0x3ff
#endif
#ifndef REPM
#define REPM 0
#endif
#define REP(k) for (int rep_ = 0; rep_ < (((REPM) >> (k)) & 1) + 1; ++rep_)

#if DBG
namespace dbg {
constexpr int NS = 4096;
__device__ __forceinline__ unsigned h32(unsigned x) { x ^= x >> 16; x *= 0x7feb352du; x ^= x >> 15; x *= 0x846ca68bu; x ^= x >> 16; return x; }
__device__ __forceinline__ void flag(unsigned* ctl, int k) { __hip_atomic_store(ctl + CW_ERR + k, 1u, __ATOMIC_RELAXED, __HIP_MEMORY_SCOPE_AGENT); }
__device__ __forceinline__ bool far(float a, float ref, float rtol, float atol) { return !(fabsf(a - ref) <= atol + rtol * fabsf(ref)); }
__device__ __forceinline__ float wmax(float v) {
#pragma unroll
    for (int o = 1; o < 64; o <<= 1) v = fmaxf(v, __shfl_xor(v, o));
    return v; }
__device__ __forceinline__ float wdot(const bf16* a, const bf16* b, int K, int lane) { float s = 0.f; for (int k = lane; k < K; k += 64) s += bf2f(a[k]) * bf2f(b[k]); return wave_sum(s); }
__device__ __forceinline__ int winrow(int col) { if (col < 768 || col >= 1536) return col; const int hb = col & ~127, d = col & 127, q = d >> 5, n = d & 31; return hb + (q >> 1) * 64 + (q & 1) * 4 + 8 * (n >> 2) + (n & 3); }
#define DBG_LOOP(s) const int gw = F.vcu * NWAVES + F.wave, NGW = F.G * NWAVES; for (int s = gw; s < NS; s += NGW)

__device__ __forceinline__ void chk_w(Frame& F, const float* W, int K, int N, const bf16* WT, int ldk, int koff, int mode, unsigned seed, bool& bad) {
    const unsigned r = h32(seed * 64u + F.lane); const int n = (r >> 8) % N, k = (r >> 20 ^ r) % K;
    const int dr = mode == 0 ? n : mode == 3 ? winrow(n) : (256 * (n / 128) + (n % 128) + (mode == 2 ? 128 : 0));
    const unsigned ref = f2bf(W[(size_t)k * N + n]);
    if ((unsigned)WT[(size_t)dr * ldk + koff + k] != ref) bad = true;
}
__device__ __forceinline__ void check_0(Frame& F, char* lds) {
    const Ptrs P = get_ptrs();
    bool bad = false;
    DBG_LOOP(s) {
        const unsigned sd = (unsigned)s * 7u;
        chk_w(F, P.w_in, DM, NIN, P.WinT, DM, 0, 3, sd + 0, bad);
        chk_w(F, P.w_oa, 512, DM, P.WoabT, DM, 0, 0, sd + 1, bad);
        chk_w(F, P.w_ob, 512, DM, P.WoabT, DM, 512, 0, sd + 2, bad);
        chk_w(F, P.w_out, DM, DM, P.WoutT, DM, 0, 0, sd + 3, bad);
        chk_w(F, P.w_gate, DM, DFF, P.WgvT, DM, 0, 1, sd + 4, bad);
        chk_w(F, P.w_val, DM, DFF, P.WgvT, DM, 0, 2, sd + 5, bad);
        chk_w(F, P.w_down, DFF, DM, P.WdT, DFF, 0, 0, sd + 6, bad);
        const int row = h32(s + 777u) % M; const float* xr = P.x + (size_t)row * DM;
        float sm = 0.f; for (int k = F.lane; k < DM; k += 64) sm += xr[k];
        const float mean = wave_sum(sm) / DM; float s2 = 0.f; for (int k = F.lane; k < DM; k += 64) { const float d = xr[k] - mean; s2 += d * d; }
        const float rstd = 1.0f / sqrtf(wave_sum(s2) / DM + LN_EPS);
        for (int k = F.lane; k < DM; k += 64) { const float ref = (xr[k] - mean) * rstd * P.ln_in_g[k] + P.ln_in_b[k]; if (far(bf2f(P.H0B[(size_t)row * DM + k]), ref, 1e-2f, 1e-2f)) bad = true; }
        const f32x2 st = P.STAT0[row]; if (far(st.x, mean, 1e-3f, 1e-4f) || far(st.y, rstd, 1e-3f, 1e-4f)) bad = true;
    }
    if (bad) flag(P.ctl, 0);
}
__device__ __forceinline__ void check_1(Frame& F, char* lds) {
    const Ptrs P = get_ptrs();
    bool bad = false;
    DBG_LOOP(s) {
        const unsigned r = h32(s + 1000u); const int row = r % M; int col = (r >> 15) % NIN; if (col >= 768 && col < 1536) col += 768;
        const float ref = wdot(P.H0B + (size_t)row * DM, P.WinT + (size_t)col * DM, DM, F.lane) + P.b_in[col];
        float got, want = ref;
        if (col < 512) got = bf2f(P.QA[(size_t)row * 512 + col]);
        else if (col < 640) got = bf2f(P.KVA[(size_t)row * 256 + col - 512]);
        else if (col < 768) got = bf2f(P.KVA[(size_t)row * 256 + 128 + col - 640]);
        else if (col < 1280) got = bf2f(P.QB[(size_t)row * 512 + col - 768]);
        else if (col < 1536) got = bf2f(P.KB[(size_t)row * 256 + col - 1280]);
        else if (col < 1792) got = bf2f(P.VB[(size_t)row * 256 + col - 1536]);
        else { got = bf2f(P.GATES[(size_t)row * 2048 + col - 1792]); want = 1.0f / (1.0f + expf(-ref)); }
        if (far(got, want, 2e-2f, 2e-2f)) bad = true;
    }
    if (bad) flag(P.ctl, 1);
}
__device__ __forceinline__ void check_2(Frame& F, char* lds) {
    const Ptrs P = get_ptrs();
    bool bad = false;
    DBG_LOOP(s) {
        const unsigned r = h32(s + 2000u); const int row = r % M, hd = (r >> 15) % 6;
        const int colbase = hd < 4 ? 768 + hd * 128 : 1280 + (hd - 4) * 128;
        const bf16* stored = hd < 4 ? P.QB + (size_t)row * 512 + hd * 128 : P.KB + (size_t)row * 256 + (hd - 4) * 128;
        const float* sc = hd < 4 ? P.bq_norm : P.bk_norm;
        float raw[2], y[2];
#pragma unroll
        for (int q = 0; q < 2; ++q) { const int d = F.lane + 64 * q; float acc = 0.f; const bf16* a = P.H0B + (size_t)row * DM; const bf16* b = P.WinT + (size_t)winrow(colbase + d) * DM;
            for (int k = 0; k < DM; ++k) acc += bf2f(a[k]) * bf2f(b[k]); raw[q] = acc + P.b_in[colbase + d]; }
        const float rstd = 1.0f / sqrtf(wave_sum(raw[0] * raw[0] + raw[1] * raw[1]) / 128.0f + RMS_EPS);
        const int ts = row & (SEQ - 1);
#pragma unroll
        for (int q = 0; q < 2; ++q) y[q] = raw[q] * rstd * sc[F.lane + 64 * q];
#pragma unroll
        for (int q = 0; q < 2; ++q) { const float py = __shfl_xor(y[q], 32); const int dd = F.lane, k = dd & 31; const int pos = q == 0 ? (ts >> 6) : (ts & 63);
            const float ang = (float)pos * powf(10000.0f, -(float)k / 32.0f), cs = cosf(ang), sn = sinf(ang);
            const float ref = dd < 32 ? (y[q] * cs - py * sn) : (py * sn + y[q] * cs);
            if (far(bf2f(stored[F.lane + 64 * q]), ref, 2e-2f, 4e-2f)) bad = true; }
    }
    if (bad) flag(P.ctl, 2);
}
__device__ __forceinline__ void check_3(Frame& F, char* lds) {
    const Ptrs P = get_ptrs();
    bool bad = false; float* pl = (float*)lds + F.wave * 4096;
    DBG_LOOP(s) {
        const unsigned r = h32(s + 3000u); int row = r % M; const int hsel = (r >> 15) % 12; const int ts = row & (SEQ - 1), b = row / SEQ;
        if (s < 512) { const int e = s & 7; const int tsn = e == 0 ? 0 : e == 1 ? 1 : e == 2 ? SEQ - 1 : e == 3 ? SEQ - 2 : e == 4 ? 127 : e == 5 ? 128 : e == 6 ? 129 : SEQ - 129; row = b * SEQ + tsn; }
        const int tq = row & (SEQ - 1);
        if (hsel < 8) {
            const int h = hsel, kvh = h >> 2; const float slope = exp2f(-(float)(h + 1)), sink = P.a_sinks[h];
            float sc[5]; float mx = sink;
#pragma unroll
            for (int j = 0; j < 5; ++j) { const int i = F.lane + 64 * j, kp = tq - 128 + i; sc[j] = -INFINITY;
                if (i < 257 && kp >= 0 && kp < SEQ) { float d = 0.f; const bf16* q = P.QA + (size_t)row * 512 + h * 64; const bf16* kk = P.KVA + ((size_t)b * SEQ + kp) * 256 + kvh * 64;
                    for (int e = 0; e < 64; ++e) d += bf2f(q[e]) * bf2f(kk[e]); sc[j] = d * 0.125f - slope * fabsf((float)(tq - kp)); }
                mx = fmaxf(mx, sc[j]); }
            mx = wmax(mx); float sm = 0.f;
#pragma unroll
            for (int j = 0; j < 5; ++j) { const float p = expf(sc[j] - mx); pl[F.lane + 64 * j] = p; sm += p; }
            const float den = wave_sum(sm) + expf(sink - mx);
            __builtin_amdgcn_s_waitcnt(0);
            float o = 0.f; for (int i = 0; i < 257; ++i) { const int kp = tq - 128 + i; if (kp >= 0 && kp < SEQ) o += pl[i] * bf2f(P.KVA[((size_t)b * SEQ + kp) * 256 + 128 + kvh * 64 + F.lane]); }
            o /= den;
            if (far(bf2f(P.OAB[(size_t)row * 1024 + h * 64 + F.lane]), o, 3e-2f, 5e-3f)) bad = true;
        } else {
            const int h = hsel - 8 < 4 ? hsel - 8 : 0, kvh = h >> 1; float mx = -INFINITY;
            const bf16* q = P.QB + (size_t)row * 512 + h * 128;
            for (int j = 0; j < 64; ++j) { const int kp = F.lane + 64 * j; const bf16* kk = P.KB + ((size_t)b * SEQ + kp) * 256 + kvh * 128; float d = 0.f;
                for (int e = 0; e < 128; ++e) d += bf2f(q[e]) * bf2f(kk[e]); d *= 0.08838834764831845f; pl[kp] = d; mx = fmaxf(mx, d); }
            mx = wmax(mx); float sm = 0.f;
            for (int j = 0; j < 64; ++j) { const int kp = F.lane + 64 * j; const float p = expf(pl[kp] - mx); pl[kp] = p; sm += p; }
            const float den = wave_sum(sm);
            __builtin_amdgcn_s_waitcnt(0);
            for (int qd = 0; qd < 2; ++qd) { float o = 0.f; for (int kp = 0; kp < SEQ; ++kp) o += pl[kp] * bf2f(P.VB[((size_t)b * SEQ + kp) * 256 + kvh * 128 + F.lane + 64 * qd]); o /= den;
                if (far(bf2f(P.OAB[(size_t)row * 1024 + 512 + h * 128 + F.lane + 64 * qd]), o, 3e-2f, 5e-3f)) bad = true; }
        }
        __builtin_amdgcn_s_waitcnt(0);
    }
    if (bad) flag(P.ctl, 3);
}
__device__ __forceinline__ void check_4(Frame& F, char* lds) {
    const Ptrs P = get_ptrs();
    bool bad = false;
    DBG_LOOP(s) {
        const unsigned r = h32(s + 4000u); const int row = r % M, col = (r >> 15) % DM;
        const float pa = wdot(P.OAB + (size_t)row * 1024, P.WoabT + (size_t)col * DM, 512, F.lane), pb = wdot(P.OAB + (size_t)row * 1024 + 512, P.WoabT + (size_t)col * DM + 512, 512, F.lane);
        const float ref = bf2f(P.GATES[(size_t)row * 2048 + col]) * pa + bf2f(P.GATES[(size_t)row * 2048 + 1024 + col]) * pb;
        if (far(bf2f(P.MERGED[(size_t)row * DM + col]), ref, 3e-2f, 1e-3f)) bad = true;
    }
    if (bad) flag(P.ctl, 4);
}
__device__ __forceinline__ void row_stats(const float* xr, int lane, float& mean, float& rstd, float& sm_, float& sq_) {
    float sm = 0.f, sq = 0.f; for (int k = lane; k < DM; k += 64) { sm += xr[k]; sq += xr[k] * xr[k]; }
    sm = wave_sum(sm); sq = wave_sum(sq); mean = sm / DM; float s2 = 0.f; for (int k = lane; k < DM; k += 64) { const float d = xr[k] - mean; s2 += d * d; }
    rstd = 1.0f / sqrtf(wave_sum(s2) / DM + LN_EPS); sm_ = sm; sq_ = sq;
}
__device__ __forceinline__ void check_5(Frame& F, char* lds) {
    const Ptrs P = get_ptrs();
    bool bad = false;
    DBG_LOOP(s) {
        const unsigned r = h32(s + 5000u); const int row = r % M, col = (r >> 15) % DM;
        const float y = wdot(P.MERGED + (size_t)row * DM, P.WoutT + (size_t)col * DM, DM, F.lane);
        float mean, rstd, a_, b_; row_stats(P.x + (size_t)row * DM, F.lane, mean, rstd, a_, b_);
        const float ref = ALPHA * ((P.x[(size_t)row * DM + col] - mean) * rstd * P.ln_in_g[col] + P.ln_in_b[col]) + y;
        if (far(P.out[(size_t)row * DM + col], ref, 1e-3f, 1e-3f)) bad = true;
        if (far(bf2f(P.H0B[(size_t)row * DM + col]), ref * P.ln1_g[col], 1e-2f, 1e-2f)) bad = true;
        float m1, r1, sm, sq; row_stats(P.out + (size_t)row * DM, F.lane, m1, r1, sm, sq);
        const float gs = (float)P.RS1[2 * (size_t)row] * (1.0f / 1099511627776.0f), gq = (float)P.RS1[2 * (size_t)row + 1] * (1.0f / 1099511627776.0f);
        if (far(gs, sm, 1e-3f, 1e-2f) || far(gq, sq, 1e-3f, 1e-2f)) bad = true;
    }
    if (bad) flag(P.ctl, 5);
}
__device__ __forceinline__ void check_6(Frame& F, char* lds) {}
__device__ __forceinline__ float h1dot(const Ptrs& P, int row, const bf16* w, int lane) {
    const float* zr = P.out + (size_t)row * DM; float mean, rstd, a_, b_; row_stats(zr, lane, mean, rstd, a_, b_);
    float s = 0.f; for (int k = lane; k < DM; k += 64) s += ((zr[k] - mean) * rstd * P.ln1_g[k] + P.ln1_b[k]) * bf2f(w[k]); return wave_sum(s);
}
__device__ __forceinline__ void check_7(Frame& F, char* lds) {
    const Ptrs P = get_ptrs();
    bool bad = false;
    DBG_LOOP(s) {
        const unsigned r = h32(s + 7000u); int row = r % M; const int ch = (r >> 15) % DFF;
        if (s < 3072) { const int e = s % 12; const int off = e == 0 ? 0 : e == 1 ? 255 : e == 2 ? 63 : e == 3 ? 64 : e == 4 ? 127 : e == 5 ? 128 : e == 6 ? 191 : e == 7 ? 192 : e == 8 ? 15 : e == 9 ? 16 : e == 10 ? 1 : 254; row = (row & ~255) + off; }
        const int ts = row & (SEQ - 1);
        const bf16* wg = P.WgvT + (size_t)(256 * (ch / 128) + (ch % 128)) * DM; const bf16* wv = wg + (size_t)128 * DM;
        const float g0 = ts > 0 ? h1dot(P, row - 1, wg, F.lane) : 0.f, g1 = h1dot(P, row, wg, F.lane);
        const float g2 = ts < SEQ - 1 ? h1dot(P, row + 1, wg, F.lane) : 0.f, v = h1dot(P, row, wv, F.lane);
        const float cv = P.conv_w[ch] * g0 + P.conv_w[DFF + ch] * g1 + P.conv_w[2 * DFF + ch] * g2 + P.conv_b[ch];
        const float ref = 0.5f * cv * (1.0f + erff(cv * 0.7071067811865476f)) * v;
        if (far(bf2f(P.ACT[(size_t)row * DFF + ch]), ref, 3e-2f, 8e-3f)) bad = true;
    }
    if (bad) flag(P.ctl, 7);
}
__device__ __forceinline__ void check_8(Frame& F, char* lds) {
    const Ptrs P = get_ptrs();
    bool bad = false;
    DBG_LOOP(s) {
        const unsigned r = h32(s + 8000u); const int row = r % M, col = (r >> 15) % DM;
        const float y = wdot(P.ACT + (size_t)row * DFF, P.WdT + (size_t)col * DFF, DFF, F.lane);
        float mu, rs; pg8::fx_stats(P.RS1, (unsigned)row, LN_EPS, mu, rs);
        const float ref = ALPHA * ((bf2f(P.H0B[(size_t)row * DM + col]) - mu * P.ln1_g[col]) * rs + P.ln1_b[col]) + y;
        if (far(P.out[(size_t)row * DM + col], ref, 1e-2f, 3e-2f)) bad = true;
    }
    if (bad) flag(P.ctl, 8);
}
}
#endif

__global__ void __launch_bounds__(NWAVES * 64, 2) fwd_megakernel(Args args) {
    extern __shared__ __attribute__((aligned(16))) unsigned char lds[];
    Frame F;
    F.lds = (LAS unsigned char*)lds;
    F.tid = threadIdx.x; F.lane = F.tid & 63; F.wave = __builtin_amdgcn_readfirstlane(F.tid >> 6);
    F.G = gridDim.x; { const int bx = blockIdx.x; F.vcu = (F.G % 8 == 0) ? (bx % 8) * (F.G / 8) + bx / 8 : bx; }
    LAS unsigned char* ring = F.lds; LAS unsigned char* xlds = F.lds + XLDS_OFF;
    const int gw = F.vcu * NWAVES + F.wave, NGW = F.G * NWAVES;
    { volatile LAS unsigned* misc = (volatile LAS unsigned*)(F.lds + MISC_OFF); if (F.tid < 16) misc[F.tid] = 0u; }
    __syncthreads();
    XcdBarrier xbar;
    { const Ptrs P = get_ptrs(); xbar = xcd_barrier_post(P.ctl + CW_BAR, (volatile LAS unsigned*)(F.lds + MISC_OFF)); }
#ifdef STAMP
    volatile LAS unsigned long long* stamps = (volatile LAS unsigned long long*)(F.lds + MISC_OFF + 128); int nst = 0;
    const bool stamper = (blockIdx.x == 0 && F.tid == 0);
#define TSTAMP() do { if (stamper) stamps[nst] = __builtin_amdgcn_s_memrealtime(); ++nst; } while (0)
#else
#define TSTAMP() do {} while (0)
#endif
    TSTAMP();
#define GRID_BAR() do { xcd_barrier(xbar); TSTAMP(); } while (0)
#if DBG
#define CHECK(k) do { dbg::check_##k(F, (char*)lds); GRID_BAR(); } while (0)
#else
#define CHECK(k) do {} while (0)
#endif

#if PHM & (1<<0)
    REP(0) { p0_prologue(F);
    GRID_BAR(); }
    CHECK(0);

#endif
#if PHM & (1<<1)
    REP(1) {
    {
        const Ptrs P = get_ptrs();
        pg8::Gemm g{P.H0B, P.WinT, DM, DM, DM}; pg8::StaticOrder S; S.init(M, NIN, F.G, (int)blockIdx.x);
        pg8::EpiU E{P.QA, P.KVA, P.QB, P.KB, P.VB, P.GATES, P.b_in, P.bq_norm, P.bk_norm, P.ROPE};
        pg8::gemm_phase<pg8::EpiU, pg8::StaticOrder, true>(ring, xlds, g, S, E);
    }
    GRID_BAR();
    CHECK(1);

#endif
#if PHM & (1<<2)
    }
    CHECK(2);

#endif
#if PHM & (1<<3)
    {
        p1c_fold_vectors(F);
        const Ptrs P = get_ptrs();
#ifndef NO_DENSE
        REP(3)
        for (int u = F.vcu; u < BATCH * 4 * (SEQ / 256); u += F.G) {
            const int qb = u & 15, h = (u >> 4) & 3, b = u >> 6, kvh = h >> 1;
            const size_t r0 = (size_t)b * SEQ + (size_t)qb * 256;
            attn::dense::body(P.QB + r0 * 512 + h * 128, P.KB + (size_t)b * SEQ * 256 + kvh * 128, P.VB + (size_t)b * SEQ * 256 + kvh * 128, P.OAB + r0 * 1024 + 512 + h * 128, SEQ, (char*)lds);
        }
#endif
        __syncthreads(); TSTAMP();
#ifndef NO_WIN
        REP(10)
        attn::win::run(P.QA, P.KVA, P.OAB, P.a_sinks, F.vcu, F.G, BATCH * 2 * (SEQ / 64), P.ctl + CW_WINQ, (char*)lds);
        TSTAMP();
#endif
    }
    GRID_BAR();
    CHECK(3);

#endif
#if PHM & (1<<4)
    REP(4) {
    {
        const Ptrs P = get_ptrs();
        pg8::Gemm g{P.OAB, P.WoabT, DM, DM, 512}; pg8::StaticOrder S; S.init(M, DM, F.G, (int)blockIdx.x, 2);
        pg8::EpiGate E{P.GATES, P.MERGED};
        pg8::gemm_phase<pg8::EpiGate, pg8::StaticOrder, true>(ring, xlds, g, S, E);
    }
    GRID_BAR(); }
    CHECK(4);

#endif
#if PHM & (1<<5)
    REP(5) {
#if (REPM >> 5) & 1
    { const Ptrs P = get_ptrs(); for (int m = gw * 64 + F.lane; m < 2 * M; m += NGW * 64) P.RS1[m] = 0; }
    GRID_BAR();
#endif
    {
        const Ptrs P = get_ptrs();
        pg8::Gemm g{P.MERGED, P.WoutT, DM, DM, DM}; pg8::StaticOrder S; S.init(M, DM, F.G, (int)blockIdx.x);
        pg8::EpiRes<true> E{P.x, P.STAT0, nullptr, P.ln_in_g, P.ln_in_b, P.out, P.RS1, P.ln1_g, P.H0B};
        pg8::gemm_phase<pg8::EpiRes<true>, pg8::StaticOrder, true>(ring, xlds, g, S, E);
    }
    GRID_BAR(); }
    CHECK(5);

#endif
#if PHM & (1<<6)
    CHECK(6);

#endif
#if PHM & (1<<7)
    REP(7) {
    {
        const Ptrs P = get_ptrs();
        pg8::Gemm g{P.H0B, P.WgvT, DM, DM, DM}; pg8::StaticOrder S; S.init(M, NGV, F.G, (int)blockIdx.x);
        pg8::EpiFfnUp E{P.ACT, P.conv_w, P.conv_b, P.Pb, P.Gb, P.Vbnd, P.RS1, P.C1, P.C2};
        pg8::gemm_phase<pg8::EpiFfnUp, pg8::StaticOrder, true>(ring, xlds, g, S, E);
    }
    GRID_BAR();
    p5b_fixup(F);
    GRID_BAR(); }
    CHECK(7);

#endif
#if PHM & (1<<8)
#if (REPM >> 8) & 1
    {
        const Ptrs P = get_ptrs();
        pg8::Gemm g{P.ACT, P.WdT, DFF, DFF, DFF}; pg8::StaticOrder S; S.init(M, DM, F.G, (int)blockIdx.x);
        pg8::EpiRes<false> E{P.out, nullptr, P.RS1, P.ln1_g, P.ln1_b, (float*)P.OAB, (long long*)P.H0B, nullptr, nullptr};
        pg8::gemm_phase<pg8::EpiRes<false>, pg8::StaticOrder, true>(ring, xlds, g, S, E);
    }
    GRID_BAR();
#endif
    {
        const Ptrs P = get_ptrs();
        pg8::Gemm g{P.ACT, P.WdT, DFF, DFF, DFF}; pg8::StaticOrder S; S.init(M, DM, F.G, (int)blockIdx.x);
        pg8::EpiRes<false> E{P.out, nullptr, P.RS1, P.ln1_g, P.ln1_b, P.out, P.RS2, nullptr, nullptr};
        pg8::gemm_phase<pg8::EpiRes<false>, pg8::StaticOrder, true>(ring, xlds, g, S, E);
    }
    GRID_BAR();
    CHECK(8);

#endif
#if PHM & (1<<9)
#if (REPM >> 9) & 1
    { const Ptrs P = get_ptrs(); for (int m = gw; m < M; m += NGW) ln_apply_row(P.out + (size_t)m * DM, P.RS2, m, P.ln2_g, P.ln2_b, (float*)P.OAB + (size_t)m * DM, F.lane); }
    GRID_BAR();
#endif
    {
        const Ptrs P = get_ptrs();
#if DBG
        float poison = 0.f;
        for (int k = 0; k < 16; ++k) if (poison == 0.f && __hip_atomic_load(P.ctl + CW_ERR + k, __ATOMIC_RELAXED, __HIP_MEMORY_SCOPE_AGENT) != 0u) poison = 64.f * (float)(k + 1);
#endif
        for (int m = gw; m < M; m += NGW) {
            ln_apply_row(P.out + (size_t)m * DM, P.RS2, m, P.ln2_g, P.ln2_b, P.out + (size_t)m * DM, F.lane);
#if DBG
            if (poison != 0.f && m == 0) { P.out[F.lane] += poison; }
#endif
        }
    }
#endif
#ifdef STAMP
    TSTAMP();
    if (stamper) { const Ptrs P = get_ptrs(); const float tot = (float)(stamps[nst - 1] - stamps[0]), ph = (float)(stamps[STAMP + 1] - stamps[STAMP]);
        P.out[0] += (STAMP == 99) ? (tot * 0.01f - STAMP_SCALE) : (STAMP_SCALE < 0.f ? (ph * 0.01f + STAMP_SCALE) : ph / tot * STAMP_SCALE); }
#endif
}

extern "C" void kernel_launch(void* const* d_in, const int* in_sizes, int n_in, void* d_out, int out_size, void* d_ws, size_t ws_size, hipStream_t stream) {
    static int grid = 0;
    if (grid == 0) {
        if (n_in != 20 || in_sizes[0] != M * DM || out_size != M * DM || ws_size < WS_END) {
            fprintf(stderr, "kernel_launch: shape mismatch: n_in %d in0 %d out %d ws %zu (need >= %zu)\n", n_in, n_in > 0 ? in_sizes[0] : -1, out_size, ws_size, (size_t)WS_END); grid = -1; return; }
        int dev = 0, cus = 0, per_cu = 0;
        if (hipGetDevice(&dev) != hipSuccess || hipDeviceGetAttribute(&cus, hipDeviceAttributeMultiprocessorCount, dev) != hipSuccess) { fprintf(stderr, "kernel_launch: device query failed\n"); grid = -1; return; }
        if (hipFuncSetAttribute((const void*)fwd_megakernel, hipFuncAttributeMaxDynamicSharedMemorySize, LDS_BYTES) != hipSuccess) { fprintf(stderr, "kernel_launch: hipFuncSetAttribute failed\n"); grid = -1; return; }
        if (hipOccupancyMaxActiveBlocksPerMultiprocessor(&per_cu, (const void*)fwd_megakernel, NWAVES * 64, LDS_BYTES) != hipSuccess || per_cu < 1) { fprintf(stderr, "kernel_launch: occupancy query failed (%d)\n", per_cu); (void)hipGetLastError(); grid = -1; return; }
        grid = cus * 1;
        fprintf(stderr, "kernel_launch: %d CUs, occupancy query %d blocks/CU, grid %d\n", cus, per_cu, grid);
    }
    if (grid < 0) return;
    if (hipMemsetAsync((char*)d_ws + WS_CTL, 0, CTL_ZERO_BYTES, stream) != hipSuccess) { fprintf(stderr, "kernel_launch: memset failed\n"); return; }
    Args a{};
    for (int i = 0; i < 20; ++i) a.in[i] = (const float*)d_in[i];
    a.out = (float*)d_out; a.ws = (unsigned char*)d_ws;
    void* kargs[] = {&a};
    const hipError_t e = hipLaunchCooperativeKernel((const void*)fwd_megakernel, dim3(grid), dim3(NWAVES * 64), kargs, LDS_BYTES, stream);
    if (e != hipSuccess) fprintf(stderr, "kernel_launch: cooperative launch failed: %s (grid %d)\n", hipGetErrorString(e), grid);
}
```
